# Optimizing an MI355X kernel written in HIP

```python
import math
import jax
import jax.numpy as jnp
from jax import lax
import numpy as np


D_MODEL = 1024
BATCH = 16
SEQ = 2048
DEPTH = 1

D_MIX = D_MODEL
DA_WIDTH = D_MIX // 2
DA_HEADS = 4
DA_VDIM = DA_WIDTH // DA_HEADS
DA_QK = DA_VDIM // 2
NSA_WIDTH = D_MIX - DA_WIDTH
NSA_HEADS = 4
NSA_HD = NSA_WIDTH // NSA_HEADS
NSA_KV_GROUPS = 1
NSA_HPG = NSA_HEADS // NSA_KV_GROUPS
CMP_LEN = 32
CMP_STRIDE = 16
SEL_LEN = 64
SEL_TOPK = 8
WINDOW = 256
Q_BLOCK = 128
SEL_Q_BLOCK = 64
NORM_EPS = 1e-6
NEG = -1e30
FORCE = 1e9
SPLIT_SIZES = (DA_WIDTH, DA_WIDTH, DA_WIDTH, DA_WIDTH, NSA_WIDTH) + (NSA_KV_GROUPS * NSA_HD,) * 6 + (3 * NSA_HEADS, NSA_WIDTH)
D_IN = 4 * DA_WIDTH + 2 * NSA_WIDTH + 6 * NSA_KV_GROUPS * NSA_HD + 3 * NSA_HEADS

kernel_name = 'hybrid_diffattn_nsa_block'


def _rmsnorm(x, g):
    xf = x.astype(jnp.float32)
    xf = xf * lax.rsqrt(jnp.mean(xf * xf, axis=-1, keepdims=True) + NORM_EPS)
    return (xf * g.astype(jnp.float32)).astype(x.dtype)


def _alibi_slopes(n):
    return jnp.asarray(2.0 ** (-8.0 * np.arange(1, n + 1) / n), dtype=jnp.float32)


def _masked_softmax(s, mask, axis=-1):
    p = jax.nn.softmax(jnp.where(mask, s, NEG), axis=axis)
    return jnp.where(mask, p, 0.0)


def _diff_attention(q, k, v, lam, slopes):
    B, T = q.shape[:2]
    nqb = T // Q_BLOCK
    qf = q.astype(jnp.float32) * DA_QK ** -0.5
    kf = k.astype(jnp.float32)
    vf = v.astype(jnp.float32)
    k_pos = jnp.arange(T)
    qb = qf.reshape(B, nqb, Q_BLOCK, DA_HEADS, 2, DA_QK).transpose(1, 0, 2, 3, 4, 5)

    def block(args):
        qblk, i = args
        q_pos = i * Q_BLOCK + jnp.arange(Q_BLOCK)
        dist = q_pos[:, None] - k_pos[None, :]
        s = jnp.einsum('bqhcd,bkhcd->bhcqk', qblk, kf) - slopes[:, None, None, None] * dist.astype(jnp.float32)
        p = jax.nn.softmax(jnp.where(dist >= 0, s, NEG), axis=-1)
        a = p[:, :, 0] - lam * p[:, :, 1]
        return jnp.einsum('bhqk,bkhd->bqhd', a, vf)

    o = lax.map(block, (qb, jnp.arange(nqb)))
    return o.transpose(1, 0, 2, 3, 4).reshape(B, T, DA_HEADS, DA_VDIM)


def _compress(raw, pos, w1, w2):
    B, T = raw.shape[:2]
    nc = (T - CMP_LEN) // CMP_STRIDE + 1
    idx = jnp.arange(nc)[:, None] * CMP_STRIDE + jnp.arange(CMP_LEN)[None, :]
    win = raw[:, idx] + pos[None, None, :, None, :]
    win = win.transpose(0, 1, 3, 2, 4).reshape(B, nc, NSA_KV_GROUPS, CMP_LEN * NSA_HD)
    return (jax.nn.gelu(win @ w1) @ w2).astype(jnp.float32)


def _cmp_to_sel_matrix(nc, nsel):
    i = np.arange(nc)[:, None]
    j = np.arange(nsel)[None, :]
    start = i * CMP_STRIDE
    end = start + CMP_LEN
    overlap = np.clip(np.minimum(end, (j + 1) * SEL_LEN) - np.maximum(start, j * SEL_LEN), 0, None)
    return jnp.asarray(overlap / CMP_LEN, dtype=jnp.float32)


def _nsa(q, kc, vc, ks, vs, kw, vw, gates, cmp_pos, w_ck1, w_ck2, w_cv1, w_cv2, slopes):
    B, T = q.shape[:2]
    qf = q.astype(jnp.float32) * NSA_HD ** -0.5
    pos = jnp.arange(T)
    sl = slopes.reshape(NSA_KV_GROUPS, NSA_HPG)

    k_cmp = _compress(kc, cmp_pos, w_ck1, w_ck2)
    v_cmp = _compress(vc, cmp_pos, w_cv1, w_cv2)
    nc = k_cmp.shape[1]
    cmp_end = jnp.arange(nc) * CMP_STRIDE + CMP_LEN - 1
    dist_c = pos[:, None] - cmp_end[None, :]
    s_c = jnp.einsum('btghd,bcgd->bghtc', qf, k_cmp) - sl[:, :, None, None] * dist_c.astype(jnp.float32)
    p_c = _masked_softmax(s_c, dist_c >= 0)
    o_cmp = jnp.einsum('bghtc,bcgd->btghd', p_c, v_cmp)

    nsel = T // SEL_LEN
    topk = min(SEL_TOPK, nsel)
    imp = jnp.einsum('bghtc,cj->bgtj', p_c, _cmp_to_sel_matrix(nc, nsel))
    blk = jnp.arange(nsel)
    cur = pos // SEL_LEN
    valid = blk[None, :] <= cur[:, None]
    forced = (blk[None, :] == 0) | (blk[None, :] == cur[:, None])
    score = jnp.where(forced, FORCE, jnp.where(valid, imp, NEG))
    top_val, top_idx = lax.top_k(score, topk)
    top_ok = top_val > NEG / 2

    ks_blocks = ks.astype(jnp.float32).reshape(B, nsel, SEL_LEN, NSA_KV_GROUPS, NSA_HD).transpose(0, 3, 1, 2, 4)
    vs_blocks = vs.astype(jnp.float32).reshape(B, nsel, SEL_LEN, NSA_KV_GROUPS, NSA_HD).transpose(0, 3, 1, 2, 4)
    nqs = T // SEL_Q_BLOCK
    q_s = qf.reshape(B, nqs, SEL_Q_BLOCK, NSA_KV_GROUPS, NSA_HPG, NSA_HD).transpose(1, 0, 3, 2, 4, 5)
    idx_s = top_idx.reshape(B, NSA_KV_GROUPS, nqs, SEL_Q_BLOCK, topk).transpose(2, 0, 1, 3, 4)
    ok_s = top_ok.reshape(B, NSA_KV_GROUPS, nqs, SEL_Q_BLOCK, topk).transpose(2, 0, 1, 3, 4)
    gather = jax.vmap(jax.vmap(lambda blocks, ix: blocks[ix]))

    def sel_block(args):
        qblk, ix, ok, i = args
        q_pos = i * SEL_Q_BLOCK + jnp.arange(SEL_Q_BLOCK)
        kg = gather(ks_blocks, ix)
        vg = gather(vs_blocks, ix)
        k_pos = ix[..., None] * SEL_LEN + jnp.arange(SEL_LEN)
        dist = q_pos[:, None, None] - k_pos
        mask = (dist >= 0) & ok[..., None]
        s = jnp.einsum('bgqhd,bgqkld->bgqhkl', qblk, kg) - sl[None, :, None, :, None, None] * dist[:, :, :, None].astype(jnp.float32)
        p = _masked_softmax(s, mask[:, :, :, None], axis=(-2, -1))
        return jnp.einsum('bgqhkl,bgqkld->bgqhd', p, vg)

    o_slc = lax.map(sel_block, (q_s, idx_s, ok_s, jnp.arange(nqs)))
    o_slc = o_slc.transpose(1, 0, 3, 2, 4, 5).reshape(B, T, NSA_KV_GROUPS, NSA_HPG, NSA_HD)

    span = WINDOW + Q_BLOCK
    kw_pad = jnp.pad(kw.astype(jnp.float32), ((0, 0), (WINDOW, 0), (0, 0), (0, 0)))
    vw_pad = jnp.pad(vw.astype(jnp.float32), ((0, 0), (WINDOW, 0), (0, 0), (0, 0)))
    nqb = T // Q_BLOCK
    q_w = qf.reshape(B, nqb, Q_BLOCK, NSA_KV_GROUPS, NSA_HPG, NSA_HD).transpose(1, 0, 2, 3, 4, 5)

    def win_block(args):
        qblk, i = args
        start = i * Q_BLOCK
        kb = lax.dynamic_slice_in_dim(kw_pad, start, span, axis=1)
        vb = lax.dynamic_slice_in_dim(vw_pad, start, span, axis=1)
        q_pos = start + jnp.arange(Q_BLOCK)
        k_pos = start - WINDOW + jnp.arange(span)
        dist = q_pos[:, None] - k_pos[None, :]
        mask = (dist >= 0) & (dist < WINDOW) & (k_pos[None, :] >= 0)
        s = jnp.einsum('bqghd,bkgd->bghqk', qblk, kb) - sl[:, :, None, None] * dist.astype(jnp.float32)
        p = _masked_softmax(s, mask)
        return jnp.einsum('bghqk,bkgd->bqghd', p, vb)

    o_win = lax.map(win_block, (q_w, jnp.arange(nqb)))
    o_win = o_win.transpose(1, 0, 2, 3, 4, 5).reshape(B, T, NSA_KV_GROUPS, NSA_HPG, NSA_HD)

    o = gates[:, :, 0, :, :, None] * o_cmp + gates[:, :, 1, :, :, None] * o_slc + gates[:, :, 2, :, :, None] * o_win
    return o.reshape(B, T, NSA_WIDTH)


def setup_inputs(seed: int = 0) -> dict:
    key = jax.random.key(seed)
    ks = jax.random.split(key, 20)
    f32 = jnp.float32

    def nrm(k, shape, s):
        return jax.random.normal(k, shape, f32) * s

    L = DEPTH
    return {
        'x': nrm(ks[0], (BATCH, SEQ, D_MODEL), 1.0),
        'c': nrm(ks[1], (BATCH, D_MODEL), 1.0),
        'w_ada': nrm(ks[2], (L, D_MODEL, 3 * D_MODEL), 0.5 * D_MODEL ** -0.5),
        'b_ada': nrm(ks[3], (L, 3 * D_MODEL), 0.01),
        'g_pre': 1.0 + nrm(ks[4], (L, D_MODEL), 0.05),
        'g_post': 1.0 + nrm(ks[5], (L, D_MODEL), 0.05),
        'w_in': nrm(ks[6], (L, D_MODEL, D_IN), D_MODEL ** -0.5),
        'w_out': nrm(ks[7], (L, D_MIX, D_MODEL), D_MIX ** -0.5),
        'lam_q1': nrm(ks[8], (L, DA_QK), 0.1),
        'lam_k1': nrm(ks[9], (L, DA_QK), 0.1),
        'lam_q2': nrm(ks[10], (L, DA_QK), 0.1),
        'lam_k2': nrm(ks[11], (L, DA_QK), 0.1),
        'g_subln': 1.0 + nrm(ks[12], (L, DA_VDIM), 0.05),
        'cmp_pos': nrm(ks[13], (L, CMP_LEN, NSA_HD), 0.02),
        'w_cmp_k1': nrm(ks[14], (L, CMP_LEN * NSA_HD, NSA_HD), (CMP_LEN * NSA_HD) ** -0.5),
        'w_cmp_k2': nrm(ks[15], (L, NSA_HD, NSA_HD), NSA_HD ** -0.5),
        'w_cmp_v1': nrm(ks[16], (L, CMP_LEN * NSA_HD, NSA_HD), (CMP_LEN * NSA_HD) ** -0.5),
        'w_cmp_v2': nrm(ks[17], (L, NSA_HD, NSA_HD), NSA_HD ** -0.5),
    }


def reference(x, c, w_ada, b_ada, g_pre, g_post, w_in, w_out, lam_q1, lam_k1, lam_q2, lam_k2,
              g_subln, cmp_pos, w_cmp_k1, w_cmp_k2, w_cmp_v1, w_cmp_v2):
    B, T, _ = x.shape
    slopes_a = _alibi_slopes(DA_HEADS)
    slopes_b = _alibi_slopes(NSA_HEADS)
    offsets = [int(o) for o in np.cumsum(SPLIT_SIZES)[:-1]]
    cond = jax.nn.silu(c)
    for l in range(DEPTH):
        mod = cond @ w_ada[l] + b_ada[l]
        shift, scale, gate = jnp.split(mod, 3, axis=-1)
        h = _rmsnorm(x, g_pre[l]) * (1.0 + scale[:, None, :]) + shift[:, None, :]
        u = h @ w_in[l]
        qa, ka, va, za, qb, kc, vc, ksl, vsl, kwn, vwn, gb, zb = jnp.split(u, offsets, axis=-1)

        lam_init = 0.8 - 0.6 * math.exp(-0.3 * l)
        lam = (jnp.exp(jnp.sum(lam_q1[l].astype(jnp.float32) * lam_k1[l].astype(jnp.float32)))
               - jnp.exp(jnp.sum(lam_q2[l].astype(jnp.float32) * lam_k2[l].astype(jnp.float32))) + lam_init)
        oa = _diff_attention(qa.reshape(B, T, DA_HEADS, 2, DA_QK), ka.reshape(B, T, DA_HEADS, 2, DA_QK),
                             va.reshape(B, T, DA_HEADS, DA_VDIM), lam, slopes_a)
        oa = _rmsnorm(oa, g_subln[l]) * (1.0 - lam_init)
        oa = oa.reshape(B, T, DA_WIDTH).astype(x.dtype) * jax.nn.silu(za)

        kv_shape = (B, T, NSA_KV_GROUPS, NSA_HD)
        gates_b = jax.nn.sigmoid(gb.astype(jnp.float32)).reshape(B, T, 3, NSA_KV_GROUPS, NSA_HPG)
        ob = _nsa(qb.reshape(B, T, NSA_KV_GROUPS, NSA_HPG, NSA_HD),
                  kc.reshape(kv_shape), vc.reshape(kv_shape), ksl.reshape(kv_shape), vsl.reshape(kv_shape),
                  kwn.reshape(kv_shape), vwn.reshape(kv_shape), gates_b,
                  cmp_pos[l], w_cmp_k1[l], w_cmp_k2[l], w_cmp_v1[l], w_cmp_v2[l], slopes_b)
        ob = ob.astype(x.dtype) * jax.nn.silu(zb)

        y = jnp.concatenate([oa, ob], axis=-1) @ w_out[l]
        x = x + gate[:, None, :] * _rmsnorm(y, g_post[l])
    return x
```

```cpp
#include <hip/hip_runtime.h>
#include <hip/hip_cooperative_groups.h>
#include <cstdio>
#include <cstdint>
namespace cg = cooperative_groups;

namespace pg8 {
#define PG8_LAS __attribute__((address_space(3)))
typedef unsigned short bf16_t;
typedef short bf16x8 __attribute__((ext_vector_type(8)));
typedef float f32x4 __attribute__((ext_vector_type(4)));
typedef unsigned u32x4 __attribute__((ext_vector_type(4)));
constexpr int BM = 256, BK = 64, HALF = 128, HTB = HALF * BK * 2  , STAGE_BYTES = 8 * HTB, NXCD = 8, WGM = 8;

__host__ __device__ __forceinline__ int lds_byte(int r, int c) { const int st = (r >> 4) * 2 + (c >> 5), rr = r & 15, cc = c & 31, ob = rr * 64 + cc * 2; return st * 1024 + (ob ^ (((ob >> 9) & 1) << 5)); }
__host__ __device__ __forceinline__ void stage_rc(int b, int& R, int& C) { const int st = b / 1024, sb = b % 1024, swz = sb ^ (((sb >> 9) & 1) << 5); R = (st >> 1) * 16 + swz / 64; C = (st & 1) * 32 + (swz % 64) / 2; }
__host__ __device__ __forceinline__ int perm32(int rho) { const int n = rho >> 4, i = rho & 15; return 8 * (i >> 2) + 4 * n + (i & 3); }

struct Unit { int pm, pn; };
struct Gemm { const bf16_t* A; const bf16_t* Bt; int M, N, K; };

struct StaticOrder {
    int nM, nN, nwg, G, c;
    __host__ __device__ void init(int M, int N, int G_, int c_) { nM = M / BM; nN = N / BM; nwg = nM * nN; G = G_; c = c_; }
    __host__ __device__ bool next(int i, Unit& u) const {
        const long L = (long)i * G + c; if (L >= nwg) return false;
        int wgid = (int)L; { const int q = nwg / NXCD, r = nwg % NXCD, xcd = wgid % NXCD, off = wgid / NXCD; wgid = (xcd < r ? xcd * (q + 1) : r * (q + 1) + (xcd - r) * q) + off; }
        const int nig = WGM * nN, gid = wgid / nig, fm = gid * WGM, gsz = (nM - fm) < WGM ? (nM - fm) : WGM;
        u.pm = fm + ((wgid % nig) % gsz); u.pn = (wgid % nig) / gsz; return true;
    }
    __device__ __forceinline__ void a_ready(const Unit&) const {}
    __device__ __forceinline__ void done(const Unit&) const {}
};

__device__ __forceinline__ unsigned cvt_pk_bf16(float lo, float hi) { unsigned r; asm volatile("v_cvt_pk_bf16_f32 %0, %1, %2" : "=v"(r) : "v"(lo), "v"(hi)); return r; }
typedef float f32x2 __attribute__((ext_vector_type(2)));
__device__ __forceinline__ f32x2 gelu_pk(f32x2 v) {
    const f32x2 av = __builtin_elementwise_abs(v), d = av * 0.2316418882f + 1.0f;
    f32x2 t; t.x = __builtin_amdgcn_rcpf(d.x); t.y = __builtin_amdgcn_rcpf(d.y);
    f32x2 q = t * 0.5307027145f + (-0.7265760135f); q = q * t + 0.7107068705f; q = q * t + (-0.142248368f); q = q * t + 0.127414796f; q = q * t;
    const f32x2 s = (v * v) * (-0.72134752044f);
    f32x2 e; e.x = __builtin_amdgcn_exp2f(s.x); e.y = __builtin_amdgcn_exp2f(s.y);
    const f32x2 m = v * (q * e), r = v - m;
    f32x2 o; o.x = v.x < 0.f ? m.x : r.x; o.y = v.y < 0.f ? m.y : r.y; return o;
}

template <int ACT  > struct EpiBf16 {
    static constexpr bool PERM = true, AFTER_DRAIN = false; static_assert(ACT == 0 || ACT == 1, "EpiBf16: ACT is 0 (none) or 1 (gelu_pk)");
    bf16_t* O; int ldc; const float* bias; int split_cols; size_t split_stride; float scale0;
    __device__ __forceinline__ void operator()(const f32x4 (&acc)[2][2][4][2], const Unit& u, int wr, int wc, int fr, int fq) const {
        const int row0 = u.pm * BM + wr * 64 + fr; int colt = u.pn * BM; bf16_t* base = O;
        float sc = 1.f; if (split_cols) { const int t = colt / split_cols; base += (size_t)t * split_stride; colt -= t * split_cols; if (t == 0) sc = scale0; }
        const int col0 = colt + wc * 32 + 8 * fq, bcol0 = u.pn * BM + wc * 32 + 8 * fq;
        f32x4 bv[2][2];
#pragma unroll
        for (int bj = 0; bj < 2; ++bj)
#pragma unroll
            for (int n = 0; n < 2; ++n) bv[bj][n] = bias ? *(const f32x4*)(bias + bcol0 + bj * HALF + 4 * n) : (f32x4){0.f, 0.f, 0.f, 0.f};
#pragma unroll
        for (int ai = 0; ai < 2; ++ai)
#pragma unroll
            for (int m = 0; m < 4; ++m) { bf16_t* rowp = base + (size_t)(row0 + ai * HALF + m * 16) * ldc + col0;
#pragma unroll
                for (int bj = 0; bj < 2; ++bj) { f32x4 v0 = acc[ai][bj][m][0] + bv[bj][0], v1 = acc[ai][bj][m][1] + bv[bj][1];
                    if (ACT == 1) { f32x2 a = gelu_pk((f32x2){v0[0], v0[1]}), b = gelu_pk((f32x2){v0[2], v0[3]}), c = gelu_pk((f32x2){v1[0], v1[1]}), d = gelu_pk((f32x2){v1[2], v1[3]});
                        v0 = (f32x4){a.x, a.y, b.x, b.y}; v1 = (f32x4){c.x, c.y, d.x, d.y}; }
                    v0 = v0 * sc; v1 = v1 * sc; u32x4 w; w.x = cvt_pk_bf16(v0[0], v0[1]); w.y = cvt_pk_bf16(v0[2], v0[3]); w.z = cvt_pk_bf16(v1[0], v1[1]); w.w = cvt_pk_bf16(v1[2], v1[3]);
                    *(u32x4*)(rowp + bj * HALF) = w; } }
    }
};

template <class Epi, class Sched, bool ALIGN_EPI = false, bool SP2 = false>
__device__ __forceinline__ void gemm_phase(PG8_LAS unsigned char* lds, const Gemm g, const Sched& S, const Epi& E) {
    const int tid = threadIdx.x, wid = __builtin_amdgcn_readfirstlane(tid >> 6), lane = tid & 63, wr = wid >> 2, wc = wid & 3, fr = lane & 15, fq = lane >> 4;
    const int K = g.K, nt = K / BK;
    unsigned voffA[2], voffB[2];
#pragma unroll
    for (int i = 0; i < 2; ++i) { int R, C; stage_rc(tid * 16 + i * 8192, R, C); const int Rb = Epi::PERM ? ((R & ~31) + perm32(R & 31)) : R;
        voffA[i] = (unsigned)(R * K + C) * 2u; voffB[i] = (unsigned)(Rb * K + C) * 2u; }
    const size_t kstep = (size_t)(BK * 2);
    const size_t hstep = (size_t)HALF * K * 2;
    const size_t tstep = 2 * hstep;
    const unsigned ldsw = (unsigned)wid * 1024u;
    const int aoff = lds_byte(wr * 64 + fr, fq * 8), boff = lds_byte(wc * 32 + fr, fq * 8);
#define PG8_SA(b, h) (((b) * 2 + (h)) * HTB)
#define PG8_SB(b, h) ((4 + (b) * 2 + (h)) * HTB)
#define PG8_STAGE(bufoff, gbase, voff) do { _Pragma("unroll") for (int _i = 0; _i < 2; ++_i) \
        __builtin_amdgcn_global_load_lds((const unsigned*)((const char*)(gbase) + (voff)[_i]), (PG8_LAS unsigned*)(lds + (bufoff) + ldsw + _i * 8192), 16, 0, 0); } while (0)
#define PG8_LDA(dst, b, h) do { _Pragma("unroll") for (int m = 0; m < 4; ++m) _Pragma("unroll") for (int k = 0; k < 2; ++k) dst[m][k] = *(const PG8_LAS bf16x8*)(lds + PG8_SA(b, h) + aoff + m * 2048 + k * 1024); } while (0)
#define PG8_LDB(dst, b, h) do { _Pragma("unroll") for (int n = 0; n < 2; ++n) _Pragma("unroll") for (int k = 0; k < 2; ++k) dst[n][k] = *(const PG8_LAS bf16x8*)(lds + PG8_SB(b, h) + boff + n * 2048 + k * 1024); } while (0)
#define PG8_MMA(ai, bj, At, Bt) do { __builtin_amdgcn_s_setprio(1); _Pragma("unroll") for (int m = 0; m < 4; ++m) _Pragma("unroll") for (int n = 0; n < 2; ++n) _Pragma("unroll") for (int k = 0; k < 2; ++k) \
        acc[ai][bj][m][n] = __builtin_amdgcn_mfma_f32_16x16x32_bf16(Bt[n][k], At[m][k], acc[ai][bj][m][n], 0, 0, 0); __builtin_amdgcn_s_setprio(0); } while (0)
#define PG8_WAIT_V(n) asm volatile("s_waitcnt vmcnt(" #n ")" ::: "memory")
#define PG8_WAIT_L(n) asm volatile("s_waitcnt lgkmcnt(" #n ")" ::: "memory")
#define PG8_BAR __builtin_amdgcn_s_barrier()
#define PG8_SCHED __builtin_amdgcn_sched_barrier(0)
    Unit cur, nxt; int ui = 0;
    if (!S.next(0, cur)) return;
    f32x4 acc[2][2][4][2];
#pragma unroll
    for (int a = 0; a < 2; ++a)
#pragma unroll
        for (int b = 0; b < 2; ++b)
#pragma unroll
            for (int m = 0; m < 4; ++m)
#pragma unroll
                for (int n = 0; n < 2; ++n) acc[a][b][m][n] = (f32x4){0.f, 0.f, 0.f, 0.f};
    bf16x8 At[4][2], B0[2][2], B1[2][2];
    const char* cA = (const char*)g.A + (size_t)cur.pm * tstep; const char* cB = (const char*)g.Bt + (size_t)cur.pn * tstep;
    S.a_ready(cur);
    if constexpr (SP2) {
        PG8_STAGE(PG8_SB(0, 0), cB, voffB); PG8_STAGE(PG8_SB(0, 1), cB + hstep, voffB); PG8_STAGE(PG8_SA(0, 0), cA, voffA); PG8_STAGE(PG8_SA(0, 1), cA + hstep, voffA);
        if (wr == 1) PG8_BAR;
        PG8_WAIT_V(2); PG8_BAR;
        PG8_STAGE(PG8_SB(1, 0), cB + kstep, voffB); PG8_STAGE(PG8_SA(1, 0), cA + kstep, voffA); PG8_STAGE(PG8_SB(1, 1), cB + hstep + kstep, voffB);
        PG8_WAIT_V(6); PG8_BAR;
    } else {
        PG8_STAGE(PG8_SB(0, 0), cB, voffB); PG8_STAGE(PG8_SA(0, 0), cA, voffA); PG8_STAGE(PG8_SB(0, 1), cB + hstep, voffB); PG8_STAGE(PG8_SA(0, 1), cA + hstep, voffA);
        if (wr == 1) PG8_BAR;
        PG8_WAIT_V(4); PG8_BAR;
        PG8_STAGE(PG8_SB(1, 0), cB + kstep, voffB); PG8_STAGE(PG8_SA(1, 0), cA + kstep, voffA); PG8_STAGE(PG8_SB(1, 1), cB + hstep + kstep, voffB);
        PG8_WAIT_V(6); PG8_BAR;
    }
    for (;;) {
        const bool has_next = S.next(ui + 1, nxt);
        const char* nA = has_next ? (const char*)g.A + (size_t)nxt.pm * tstep : cA; const char* nB = has_next ? (const char*)g.Bt + (size_t)nxt.pn * tstep : cB;
        for (int t = 0; t < nt; t += 2) {
            const bool last = (t == nt - 2);
            const char* a1 = cA + (size_t)(t + 1) * kstep;
            const char* a2 = last ? nA : cA + (size_t)(t + 2) * kstep; const char* b2 = last ? nB : cB + (size_t)(t + 2) * kstep;
            const char* a3 = a2 + kstep; const char* b3 = b2 + kstep;
            if (last && has_next) S.a_ready(nxt);
            if constexpr (SP2) {
            PG8_LDB(B0, 0, 0); PG8_LDB(B1, 0, 1); PG8_SCHED; PG8_LDA(At, 0, 0); PG8_STAGE(PG8_SA(1, 1), a1 + hstep, voffA);
            PG8_WAIT_V(8); PG8_WAIT_L(0); PG8_BAR; PG8_MMA(0, 0, At, B0); PG8_MMA(0, 1, At, B1); PG8_BAR; PG8_SCHED;
            PG8_LDA(At, 0, 1); PG8_STAGE(PG8_SB(0, 0), b2, voffB); PG8_STAGE(PG8_SB(0, 1), b2 + hstep, voffB); PG8_STAGE(PG8_SA(0, 0), a2, voffA);
            PG8_WAIT_V(8); PG8_WAIT_L(0); PG8_BAR; PG8_MMA(1, 0, At, B0); PG8_MMA(1, 1, At, B1); PG8_BAR; PG8_SCHED;
            PG8_LDB(B0, 1, 0); PG8_LDB(B1, 1, 1); PG8_SCHED; PG8_LDA(At, 1, 0); PG8_STAGE(PG8_SA(0, 1), a2 + hstep, voffA);
            PG8_WAIT_V(8); PG8_WAIT_L(0); PG8_BAR; PG8_MMA(0, 0, At, B0); PG8_MMA(0, 1, At, B1); PG8_BAR; PG8_SCHED;
            PG8_LDA(At, 1, 1); PG8_STAGE(PG8_SB(1, 0), b3, voffB); PG8_STAGE(PG8_SB(1, 1), b3 + hstep, voffB); PG8_STAGE(PG8_SA(1, 0), a3, voffA);
            PG8_WAIT_V(8); PG8_WAIT_L(0); PG8_BAR; PG8_MMA(1, 0, At, B0); PG8_MMA(1, 1, At, B1); PG8_BAR; PG8_SCHED;
            } else {
            PG8_LDB(B0, 0, 0); PG8_SCHED; PG8_LDA(At, 0, 0); PG8_STAGE(PG8_SA(1, 1), a1 + hstep, voffA);
            PG8_WAIT_L(8); PG8_BAR; PG8_WAIT_L(0); PG8_MMA(0, 0, At, B0); PG8_BAR; PG8_SCHED;
            PG8_LDB(B1, 0, 1); PG8_STAGE(PG8_SB(0, 0), b2, voffB);
            PG8_BAR; PG8_WAIT_L(0); PG8_MMA(0, 1, At, B1); PG8_BAR;
            PG8_LDA(At, 0, 1); PG8_STAGE(PG8_SA(0, 0), a2, voffA);
            PG8_BAR; PG8_WAIT_L(0); PG8_MMA(1, 0, At, B0); PG8_BAR; PG8_SCHED;
            PG8_STAGE(PG8_SB(0, 1), b2 + hstep, voffB);
            PG8_WAIT_V(6); PG8_BAR; PG8_MMA(1, 1, At, B1); PG8_BAR;
            PG8_LDB(B0, 1, 0); PG8_SCHED; PG8_LDA(At, 1, 0); PG8_STAGE(PG8_SA(0, 1), a2 + hstep, voffA);
            PG8_WAIT_L(8); PG8_BAR; PG8_WAIT_L(0); PG8_MMA(0, 0, At, B0); PG8_BAR; PG8_SCHED;
            PG8_LDB(B1, 1, 1); PG8_STAGE(PG8_SB(1, 0), b3, voffB);
            PG8_BAR; PG8_WAIT_L(0); PG8_MMA(0, 1, At, B1); PG8_BAR;
            PG8_LDA(At, 1, 1); PG8_STAGE(PG8_SA(1, 0), a3, voffA);
            PG8_BAR; PG8_WAIT_L(0); PG8_MMA(1, 0, At, B0); PG8_BAR; PG8_SCHED;
            PG8_STAGE(PG8_SB(1, 1), b3 + hstep, voffB);
            PG8_WAIT_V(6); PG8_BAR; PG8_MMA(1, 1, At, B1); PG8_BAR;
            }
        }
        if constexpr (ALIGN_EPI) { if (wr == 0) PG8_BAR; }
        if constexpr (!Epi::AFTER_DRAIN) { E(acc, cur, wr, wc, fr, fq); S.done(cur); }
        if (!has_next) break;
#pragma unroll
        for (int a = 0; a < 2; ++a)
#pragma unroll
            for (int b = 0; b < 2; ++b)
#pragma unroll
                for (int m = 0; m < 4; ++m)
#pragma unroll
                    for (int n = 0; n < 2; ++n) acc[a][b][m][n] = (f32x4){0.f, 0.f, 0.f, 0.f};
        cur = nxt; cA = nA; cB = nB; ++ui;
        if constexpr (ALIGN_EPI) { if (wr == 1) PG8_BAR; }
    }
    PG8_WAIT_V(0);
    if constexpr (!ALIGN_EPI) { if (wr == 0) PG8_BAR; }
    PG8_BAR;
    if constexpr (Epi::AFTER_DRAIN) { E.fused(acc, cur, wr, wc, fr, fq, lds, wid, lane); S.done(cur); }
#undef PG8_SA
#undef PG8_SB
#undef PG8_STAGE
#undef PG8_LDA
#undef PG8_LDB
#undef PG8_MMA
#undef PG8_WAIT_V
#undef PG8_WAIT_L
#undef PG8_BAR
#undef PG8_SCHED
}
}


constexpr int NB = 16, T = 2048, DM = 1024, M = NB * T;
constexpr int UP = 3840;
constexpr int C_QA = 0, C_KA = 512, C_VA = 1024, C_ZA = 1536, C_QB = 2048, C_KC = 2560, C_VC = 2688, C_KS = 2816, C_VS = 2944, C_KW = 3072, C_VW = 3200, C_ZB = 3328;
constexpr int DIN_SRC = 3852, GATE_SRC = 3328;
constexpr int NCMP = 127;
constexpr float LOG2E = 1.4426950408889634f;
constexpr float QA_SCALE = 0.125f * LOG2E;
constexpr float QB_SCALE = 0.08838834764831845f * LOG2E;
constexpr float NORM_EPS = 1e-6f;
constexpr float LAM_INIT = 0.2f;

constexpr size_t MiB = 1u << 20;
constexpr size_t WS_CTL = 0;
constexpr size_t WS_WIN = 2 * MiB;
constexpr size_t WS_WOUT = 10 * MiB;
constexpr size_t WS_WK1 = 12 * MiB, WS_WV1 = 13 * MiB;
constexpr size_t WS_WK2 = 14 * MiB, WS_WV2 = 14 * MiB + 65536;
constexpr size_t WS_MOD = 15 * MiB;
constexpr size_t WS_B1P = 15 * MiB + 524288;
constexpr size_t WS_KCMP = 16 * MiB, WS_VCMP = 16 * MiB + 524288;
constexpr size_t WS_GATES = 18 * MiB;
constexpr size_t WS_H = 32 * MiB;
constexpr size_t WS_Y = 32 * MiB;
constexpr size_t WS_U = 96 * MiB;
constexpr size_t WS_CAT = 336 * MiB;
constexpr size_t WS_NSAACC = 400 * MiB;
constexpr size_t WS_END = 432 * MiB;
constexpr int CTL_BYTES = 4096;
constexpr int CW_Q3 = 0, CW_Q4 = 64;

constexpr int LDS_BYTES = 147456;
constexpr int KSTR = 272, VSTR = 320;
constexpr int KT_BYTES = 64 * KSTR, VT_BYTES = 64 * VSTR, BUF_BYTES = KT_BYTES + VT_BYTES;
constexpr int L_BUF0 = 0, L_BUF1 = BUF_BYTES, L_XCH = 77824, L_MISC = 143360;
static_assert(2 * BUF_BYTES <= L_XCH && L_XCH + 65536 <= L_MISC && L_MISC + 4096 <= LDS_BYTES, "LDS map");

#define LAS __attribute__((address_space(3)))
typedef unsigned short bf16;
typedef short bf16x8 __attribute__((ext_vector_type(8)));
typedef short s16x4 __attribute__((ext_vector_type(4)));
typedef float f32x4 __attribute__((ext_vector_type(4)));
typedef float f32x16 __attribute__((ext_vector_type(16)));
typedef unsigned u32x4 __attribute__((ext_vector_type(4)));
typedef unsigned u32x2 __attribute__((ext_vector_type(2)));
typedef float f32x2_t __attribute__((ext_vector_type(2)));
typedef __bf16 bf16x2_t __attribute__((ext_vector_type(2)));

__device__ __forceinline__ unsigned pk2(float lo, float hi) { f32x2_t v = {lo, hi}; bf16x2_t b = __builtin_convertvector(v, bf16x2_t); return __builtin_bit_cast(unsigned, b); }
__device__ __forceinline__ float bf2f(unsigned short u) { return __uint_as_float((unsigned)u << 16); }
__device__ __forceinline__ float bflo(unsigned w) { return __uint_as_float(w << 16); }
__device__ __forceinline__ float bfhi(unsigned w) { return __uint_as_float(w & 0xffff0000u); }
__device__ __forceinline__ float wave_sum(float v) {
#pragma unroll
    for (int o = 1; o < 64; o <<= 1) v += __shfl_xor(v, o);
    return v;
}
__device__ __forceinline__ float xhalf_max(float v) { auto rr = __builtin_amdgcn_permlane32_swap(__float_as_uint(v), __float_as_uint(v), false, false); return fmaxf(__uint_as_float(rr[0]), __uint_as_float(rr[1])); }
__device__ __forceinline__ float xhalf_sum(float v) { auto rr = __builtin_amdgcn_permlane32_swap(__float_as_uint(v), __float_as_uint(v), false, false); return __uint_as_float(rr[0]) + __uint_as_float(rr[1]); }
__device__ __forceinline__ float silu_f(float v) { return v / (1.f + __expf(-v)); }
__device__ __forceinline__ float sigmoid_f(float v) { return 1.f / (1.f + __expf(-v)); }
__device__ __forceinline__ float gelu_tanh(float x) { const float u = 0.7978845608028654f * (x + 0.044715f * x * x * x); const float e = __expf(2.f * u); const float th = 1.f - 2.f / (1.f + e); return 0.5f * x * (1.f + th); }
__device__ __forceinline__ int crow(int r, int hi) { return (r & 3) + 8 * (r >> 2) + 4 * hi; }
__device__ __forceinline__ bf16x8 pack8(const f32x16& p, int b0) {
    u32x4 w = {pk2(p[b0 + 0], p[b0 + 1]), pk2(p[b0 + 2], p[b0 + 3]), pk2(p[b0 + 4], p[b0 + 5]), pk2(p[b0 + 6], p[b0 + 7])};
    return __builtin_bit_cast(bf16x8, w);
}
typedef short v4i16_t __attribute__((ext_vector_type(4)));
__device__ __forceinline__ s16x4 vtr(LAS const unsigned char* p) { return __builtin_bit_cast(s16x4, __builtin_amdgcn_ds_read_tr16_b64_v4i16((LAS v4i16_t*)p)); }
#define MFMA32(a, b, c) __builtin_amdgcn_mfma_f32_32x32x16_bf16((a), (b), (c), 0, 0, 0)

struct Args {
    const float* in[18]; float* out; unsigned char* ws; int ph_lo, ph_hi;
};

struct Ctx {
    LAS unsigned char* lds;
    unsigned char* ws;
    int tid, lane, wave, G, bid;
};

__device__ __forceinline__ void transpose_item(const float* W, int K, int Nsrc, int Ndst, bf16* WT, LAS float* scr, int item, int lane, int mode) {
    const int nblk = Ndst / 32, kb = item / nblk, nb = item % nblk, k0 = 64 * kb, n0 = 32 * nb;
    int s0 = n0; float sc = 1.f;
    if (mode == 1) { if (n0 >= GATE_SRC) s0 = n0 + 12; if (n0 < 512) sc = QA_SCALE; else if (n0 >= C_QB && n0 < C_QB + 512) sc = QB_SCALE; }
#pragma unroll 8
    for (int i = 0; i < 32; ++i) { const int kk = 2 * i + (lane >> 5); scr[kk * 33 + (lane & 31)] = W[(size_t)(k0 + kk) * Nsrc + s0 + (lane & 31)] * sc; }
    asm volatile("s_waitcnt lgkmcnt(0)" ::: "memory");
    const int c = lane & 7;
#pragma unroll
    for (int j = 0; j < 4; ++j) { const int n = (lane >> 3) + 8 * j; const LAS float* s = scr + (8 * c) * 33 + n;
        u32x4 o; o.x = pk2(s[0 * 33], s[1 * 33]); o.y = pk2(s[2 * 33], s[3 * 33]); o.z = pk2(s[4 * 33], s[5 * 33]); o.w = pk2(s[6 * 33], s[7 * 33]);
        *(u32x4*)(WT + (size_t)(n0 + n) * K + k0 + 8 * c) = o; }
    asm volatile("s_waitcnt lgkmcnt(0)" ::: "memory");
}

__device__ __forceinline__ void p0_prologue(const Ctx& X, const Args& a) {
    const float* c_in = a.in[1]; const float* w_ada = a.in[2]; const float* b_ada = a.in[3];
    const float* w_in = a.in[6]; const float* w_out = a.in[7]; const float* cmp_pos = a.in[13];
    const float* wk1 = a.in[14]; const float* wk2 = a.in[15]; const float* wv1 = a.in[16]; const float* wv2 = a.in[17];
    if (X.bid < 96) {
        LAS float* cond = (LAS float*)(X.lds);
        LAS float* red = (LAS float*)(X.lds + 65536);
        for (int e = X.tid; e < NB * DM; e += 512) { const int b = e >> 10, k = e & 1023; cond[k * 16 + b] = silu_f(c_in[e]); }
        __syncthreads();
        const int j0 = 32 * X.bid, cg4 = X.lane & 7, ks = X.lane >> 3;
        float acc[4][16];
#pragma unroll
        for (int c = 0; c < 4; ++c)
#pragma unroll
            for (int b = 0; b < 16; ++b) acc[c][b] = 0.f;
        for (int it = 0; it < 16; ++it) {
            const int k = 128 * X.wave + 8 * it + ks;
            const f32x4 wv = *(const f32x4*)(w_ada + (size_t)k * 3072 + j0 + 4 * cg4);
            const LAS f32x4* cp = (const LAS f32x4*)(cond + k * 16);
#pragma unroll
            for (int b4 = 0; b4 < 4; ++b4) { const f32x4 cv = cp[b4];
#pragma unroll
                for (int bb = 0; bb < 4; ++bb)
#pragma unroll
                    for (int c = 0; c < 4; ++c) acc[c][b4 * 4 + bb] += wv[c] * cv[bb]; }
        }
#pragma unroll
        for (int c = 0; c < 4; ++c)
#pragma unroll
            for (int b = 0; b < 16; ++b) { float v = acc[c][b]; v += __shfl_xor(v, 8); v += __shfl_xor(v, 16); v += __shfl_xor(v, 32); acc[c][b] = v; }
        if (ks == 0) {
#pragma unroll
            for (int c = 0; c < 4; ++c)
#pragma unroll
                for (int b = 0; b < 16; ++b) red[(X.wave * 32 + 4 * cg4 + c) * 16 + b] = acc[c][b];
        }
        __syncthreads();
        { const int col = X.tid >> 4, b = X.tid & 15; float s = 0.f;
#pragma unroll
          for (int w = 0; w < 8; ++w) s += red[(w * 32 + col) * 16 + b];
          float* mod = (float*)(X.ws + WS_MOD);
          mod[b * 3072 + j0 + col] = s + b_ada[j0 + col]; }
        __syncthreads();
    }
    LAS float* scr = (LAS float*)(X.lds + X.wave * 16384);
    const int gw = X.bid * 8 + X.wave, NGW = X.G * 8;
    constexpr int I_IN = 16 * 120, I_OUT = 16 * 32, I_C1 = 64 * 4, I_C2 = 2 * 4, I_B1 = 128;
    constexpr int NITEMS = I_IN + I_OUT + 2 * I_C1 + 2 * I_C2 + I_B1;
    for (int it = gw; it < NITEMS; it += NGW) {
        int r = it;
        if (r < I_IN) { transpose_item(w_in, 1024, DIN_SRC, UP, (bf16*)(X.ws + WS_WIN), scr, r, X.lane, 1); continue; } r -= I_IN;
        if (r < I_OUT) { transpose_item(w_out, 1024, 1024, 1024, (bf16*)(X.ws + WS_WOUT), scr, r, X.lane, 0); continue; } r -= I_OUT;
        if (r < I_C1) { transpose_item(wk1, 4096, 128, 128, (bf16*)(X.ws + WS_WK1), scr, r, X.lane, 0); continue; } r -= I_C1;
        if (r < I_C1) { transpose_item(wv1, 4096, 128, 128, (bf16*)(X.ws + WS_WV1), scr, r, X.lane, 0); continue; } r -= I_C1;
        if (r < I_C2) { transpose_item(wk2, 128, 128, 128, (bf16*)(X.ws + WS_WK2), scr, r, X.lane, 0); continue; } r -= I_C2;
        if (r < I_C2) { transpose_item(wv2, 128, 128, 128, (bf16*)(X.ws + WS_WV2), scr, r, X.lane, 0); continue; } r -= I_C2;
        {
            const int kv = r >> 6, p = r & 63; const float* w1 = kv ? wv1 : wk1;
            float a0 = 0.f, a1 = 0.f;
#pragma unroll 8
            for (int kk = 0; kk < 64; ++kk) { const int k = 64 * p + kk; const float pv = cmp_pos[k]; a0 += pv * w1[(size_t)k * 128 + X.lane]; a1 += pv * w1[(size_t)k * 128 + 64 + X.lane]; }
            float* bp = (float*)(X.ws + WS_B1P) + (kv * 64 + p) * 128; bp[X.lane] = a0; bp[64 + X.lane] = a1;
        }
    }
}

__device__ __forceinline__ void p1_norm(const Ctx& X, const Args& a) {
    const float* x = a.in[0]; const float* g_pre = a.in[4]; const float* w_in = a.in[6];
    const float* mod = (const float*)(X.ws + WS_MOD);
    bf16* H = (bf16*)(X.ws + WS_H); float* G = (float*)(X.ws + WS_GATES);
    LAS float* Wg = (LAS float*)X.lds;
    for (int k = X.tid; k < 1024; k += 512) {
        const f32x4* src = (const f32x4*)(w_in + (size_t)k * DIN_SRC + GATE_SRC);
        LAS f32x4* dst = (LAS f32x4*)(Wg + k * 12); dst[0] = src[0]; dst[1] = src[1]; dst[2] = src[2];
    }
    __syncthreads();
    const int gw = X.bid * 8 + X.wave, NGW = X.G * 8;
    for (int grp = gw; grp < M / 16; grp += NGW) {
        const int row0 = grp * 16, b = row0 / T;
        f32x4 gs[4], sh[4];
#pragma unroll
        for (int j = 0; j < 4; ++j) { const int k = 256 * j + 4 * X.lane;
            const f32x4 g = *(const f32x4*)(g_pre + k), sc = *(const f32x4*)(mod + b * 3072 + 1024 + k); sh[j] = *(const f32x4*)(mod + b * 3072 + k);
            gs[j] = g * (1.f + sc); }
        constexpr int RP = 2;
        for (int ps = 0; ps < 16 / RP; ++ps) {
            asm volatile("" ::: "memory");
            f32x4 xv[RP][4]; float rs[RP];
#pragma unroll
            for (int r = 0; r < RP; ++r) { const float* xr = x + (size_t)(row0 + RP * ps + r) * DM + 4 * X.lane; float s = 0.f;
#pragma unroll
                for (int j = 0; j < 4; ++j) { xv[r][j] = *(const f32x4*)(xr + 256 * j); const f32x4 v = xv[r][j]; s += (v.x * v.x + v.y * v.y) + (v.z * v.z + v.w * v.w); }
                rs[r] = s; }
#pragma unroll
            for (int r = 0; r < RP; ++r) rs[r] = rsqrtf(wave_sum(rs[r]) * (1.f / DM) + NORM_EPS);
            float ga[RP][12];
#pragma unroll
            for (int r = 0; r < RP; ++r)
#pragma unroll
                for (int g = 0; g < 12; ++g) ga[r][g] = 0.f;
#pragma unroll
            for (int j = 0; j < 4; ++j) {
#pragma unroll
                for (int r = 0; r < RP; ++r) { xv[r][j] = xv[r][j] * rs[r] * gs[j] + sh[j];
                    u32x2 o; o.x = pk2(xv[r][j].x, xv[r][j].y); o.y = pk2(xv[r][j].z, xv[r][j].w);
                    *(u32x2*)(H + (size_t)(row0 + RP * ps + r) * DM + 256 * j + 4 * X.lane) = o; }
#pragma unroll
                for (int e = 0; e < 4; ++e) { const LAS f32x4* wp = (const LAS f32x4*)(Wg + (256 * j + 4 * X.lane + e) * 12);
                    const f32x4 w0 = wp[0], w1 = wp[1], w2 = wp[2];
#pragma unroll
                    for (int r = 0; r < RP; ++r) { const float hv = xv[r][j][e];
                        ga[r][0] += hv * w0.x; ga[r][1] += hv * w0.y; ga[r][2] += hv * w0.z; ga[r][3] += hv * w0.w;
                        ga[r][4] += hv * w1.x; ga[r][5] += hv * w1.y; ga[r][6] += hv * w1.z; ga[r][7] += hv * w1.w;
                        ga[r][8] += hv * w2.x; ga[r][9] += hv * w2.y; ga[r][10] += hv * w2.z; ga[r][11] += hv * w2.w; } }
            }
#pragma unroll
            for (int r = 0; r < RP; ++r)
#pragma unroll
                for (int g = 0; g < 12; ++g) ga[r][g] = wave_sum(ga[r][g]);
            if (X.lane < RP * 12) { const int r = X.lane / 12, g = X.lane % 12; float v = 0.f;
#pragma unroll
                for (int rr = 0; rr < RP; ++rr)
#pragma unroll
                    for (int gg = 0; gg < 12; ++gg) if (rr == r && gg == g) v = ga[rr][gg];
                G[(size_t)(row0 + RP * ps + r) * 16 + g] = sigmoid_f(v); }
        }
    }
}

__device__ __forceinline__ void p6_final(const Ctx& X, const Args& a) {
    const float* x = a.in[0]; const float* g_post = a.in[5]; float* out = a.out;
    const float* mod = (const float*)(X.ws + WS_MOD); const bf16* Y = (const bf16*)(X.ws + WS_Y);
    const int gw = X.bid * 8 + X.wave, NGW = X.G * 8;
    for (int grp = gw; grp < M / 16; grp += NGW) {
        const int row0 = grp * 16, b = row0 / T;
        f32x4 gp[2][2];
#pragma unroll
        for (int j = 0; j < 2; ++j)
#pragma unroll
            for (int e = 0; e < 2; ++e) { const int k = 512 * j + 8 * X.lane + 4 * e; gp[j][e] = *(const f32x4*)(g_post + k) * *(const f32x4*)(mod + b * 3072 + 2048 + k); }
        for (int r = 0; r < 16; ++r) {
            const size_t ro = (size_t)(row0 + r) * DM;
            u32x4 yv[2]; f32x4 xv[2][2]; float s = 0.f;
#pragma unroll
            for (int j = 0; j < 2; ++j) { yv[j] = *(const u32x4*)(Y + ro + 512 * j + 8 * X.lane); xv[j][0] = *(const f32x4*)(x + ro + 512 * j + 8 * X.lane); xv[j][1] = *(const f32x4*)(x + ro + 512 * j + 8 * X.lane + 4); }
            f32x4 yf[2][2];
#pragma unroll
            for (int j = 0; j < 2; ++j) { yf[j][0] = (f32x4){bflo(yv[j].x), bfhi(yv[j].x), bflo(yv[j].y), bfhi(yv[j].y)}; yf[j][1] = (f32x4){bflo(yv[j].z), bfhi(yv[j].z), bflo(yv[j].w), bfhi(yv[j].w)};
#pragma unroll
                for (int e = 0; e < 2; ++e) { const f32x4 v = yf[j][e]; s += (v.x * v.x + v.y * v.y) + (v.z * v.z + v.w * v.w); } }
            const float rstd = rsqrtf(wave_sum(s) * (1.f / DM) + NORM_EPS);
#pragma unroll
            for (int j = 0; j < 2; ++j)
#pragma unroll
                for (int e = 0; e < 2; ++e) *(f32x4*)(out + ro + 512 * j + 8 * X.lane + 4 * e) = xv[j][e] + yf[j][e] * rstd * gp[j][e];
        }
    }
}

__device__ __forceinline__ void stage_load(u32x4 (&r)[4], const bf16* Kg, const bf16* Vg, int pitch, int tid) {
#pragma unroll
    for (int i = 0; i < 2; ++i) { const int c = tid + 512 * i, key = c >> 4, col = c & 15;
        r[i] = *(const u32x4*)(Kg + (size_t)key * pitch + col * 8); r[2 + i] = *(const u32x4*)(Vg + (size_t)key * pitch + col * 8); }
}
__device__ __forceinline__ void stage_store(LAS unsigned char* buf, const u32x4 (&r)[4], int tid) {
#pragma unroll
    for (int i = 0; i < 2; ++i) { const int c = tid + 512 * i, key = c >> 4, col = c & 15;
        *(LAS u32x4*)(buf + key * KSTR + col * 16) = r[i]; *(LAS u32x4*)(buf + KT_BYTES + key * VSTR + col * 16) = r[2 + i]; }
}
template <int KS>
__device__ __forceinline__ void qk_tile(f32x16& p0, f32x16& p1, LAS const unsigned char* kb, const bf16x8 (&qf)[KS]) {
#pragma unroll
    for (int r = 0; r < 16; ++r) { p0[r] = 0.f; p1[r] = 0.f; }
#pragma unroll
    for (int s = 0; s < KS; ++s) {
        const bf16x8 a0 = *(LAS const bf16x8*)(kb + s * 32), a1 = *(LAS const bf16x8*)(kb + 32 * KSTR + s * 32);
        p0 = MFMA32(a0, qf[s], p0); p1 = MFMA32(a1, qf[s], p1);
        if (s & 1) __builtin_amdgcn_sched_barrier(0);
    }
}
__device__ __forceinline__ void pv_tile(f32x16 (&o)[4], LAS const unsigned char* vb, bf16x8 pb0, bf16x8 pb1, bf16x8 pb2, bf16x8 pb3) {
#pragma unroll
    for (int db = 0; db < 4; ++db) {
        s16x4 lo[4], hi[4];
#pragma unroll
        for (int ks = 0; ks < 4; ++ks) { lo[ks] = vtr(vb + (16 * ks) * VSTR + db * 64); hi[ks] = vtr(vb + (16 * ks + 8) * VSTR + db * 64); }
#define PKV(k) (bf16x8){lo[k][0], lo[k][1], lo[k][2], lo[k][3], hi[k][0], hi[k][1], hi[k][2], hi[k][3]}
        o[db] = MFMA32(PKV(0), pb0, o[db]); o[db] = MFMA32(PKV(1), pb1, o[db]); o[db] = MFMA32(PKV(2), pb2, o[db]); o[db] = MFMA32(PKV(3), pb3, o[db]);
#undef PKV
        __builtin_amdgcn_sched_barrier(0);
    }
}

template <int KS>
__device__ __forceinline__ void attend(const Ctx& X, f32x16 (&o)[4], float& m, float& l, const bf16x8 (&qf)[KS], const bf16* Kg, const bf16* Vg, int kcolB,
                                       unsigned tilemask, int qp, int qw0, int W, unsigned selbits, float s2, int refpos) {
    const int lane = X.lane, hi = lane >> 5, q5 = lane & 31;
    const int koff = q5 * KSTR + hi * 16 + kcolB;
    const int voff = KT_BYTES + (4 * hi + ((lane & 15) >> 2)) * VSTR + (16 * ((lane >> 4) & 1) + 4 * (lane & 3)) * 2;
    const float NEGINF = -__builtin_inff();
    unsigned tm = tilemask;
    int jt = __ffs(tm) - 1; tm &= tm - 1;
    u32x4 sr[4];
    stage_load(sr, Kg + (size_t)(64 * jt) * UP, Vg + (size_t)(64 * jt) * UP, UP, X.tid);
    stage_store(X.lds + L_BUF0, sr, X.tid);
    __syncthreads();
    int cur = 0;
    for (;;) {
        const int jn = tm ? (__ffs(tm) - 1) : -1;
        if (jn >= 0) { tm &= tm - 1; stage_load(sr, Kg + (size_t)(64 * jn) * UP, Vg + (size_t)(64 * jn) * UP, UP, X.tid); }
        LAS const unsigned char* buf = X.lds + (cur ? L_BUF1 : L_BUF0);
        const bool lanebit = (selbits >> jt) & 1u;
        const bool skip = (64 * jt > qw0 + 31) || (qw0 - 64 * jt - 63 >= W) || !__any(lanebit);
        if (!skip) {
            f32x16 p0, p1;
            qk_tile<KS>(p0, p1, buf + koff, qf);
            const float bb = s2 * (float)(64 * jt + 4 * hi - refpos);
#pragma unroll
            for (int r = 0; r < 16; ++r) { const int c = (r & 3) + 8 * (r >> 2); p0[r] += fmaf(s2, (float)c, bb); p1[r] += fmaf(s2, (float)(c + 32), bb); }
            const bool needmask = !__all(lanebit) || (64 * jt + 63 > qw0) || (qw0 + 31 - 64 * jt >= W);
            if (needmask) {
                const int dq = qp - 64 * jt - 4 * hi;
#pragma unroll
                for (int r = 0; r < 16; ++r) { const int c = (r & 3) + 8 * (r >> 2);
                    if (!(lanebit && (unsigned)(dq - c) < (unsigned)W)) p0[r] = NEGINF;
                    if (!(lanebit && (unsigned)(dq - c - 32) < (unsigned)W)) p1[r] = NEGINF; }
            }
            float mx = fmaxf(p0[0], p1[0]);
#pragma unroll
            for (int r = 1; r < 16; ++r) mx = fmaxf(mx, fmaxf(p0[r], p1[r]));
            mx = xhalf_max(mx);
            if (!__all(mx - m <= 8.f)) {
                const float mn = fmaxf(m, mx), alpha = __builtin_amdgcn_exp2f(m - mn); m = mn; l *= alpha;
#pragma unroll
                for (int db = 0; db < 4; ++db) o[db] = o[db] * alpha;
            }
            float ps = 0.f;
#pragma unroll
            for (int r = 0; r < 16; ++r) { p0[r] = __builtin_amdgcn_exp2f(p0[r] - m); p1[r] = __builtin_amdgcn_exp2f(p1[r] - m); ps += p0[r] + p1[r]; }
            l += xhalf_sum(ps);
            pv_tile(o, buf + voff, pack8(p0, 0), pack8(p0, 8), pack8(p1, 0), pack8(p1, 8));
        }
        if (jn >= 0) stage_store(X.lds + (cur ? L_BUF0 : L_BUF1), sr, X.tid);
        __syncthreads();
        if (jn < 0) break;
        jt = jn; cur ^= 1;
    }
}

__device__ __forceinline__ void diff_unit(const Ctx& X, const Args& a, int b, int h, int qb) {
    const bf16* U = (const bf16*)(X.ws + WS_U); bf16* CAT = (bf16*)(X.ws + WS_CAT);
    const int w = X.wave, lane = X.lane, c = w >> 2, tq = w & 3, hi = lane >> 5, q5 = lane & 31;
    const int qw0 = 128 * qb + 32 * tq, qp = qw0 + q5;
    const size_t row = (size_t)b * T + qp;
    bf16x8 qf[4];
#pragma unroll
    for (int s = 0; s < 4; ++s) qf[s] = *(const bf16x8*)(U + row * UP + C_QA + 128 * h + 64 * c + 16 * s + 8 * hi);
    const float s2 = exp2f(-2.f * (float)(h + 1)) * LOG2E;
    f32x16 o[4];
#pragma unroll
    for (int db = 0; db < 4; ++db)
#pragma unroll
        for (int r = 0; r < 16; ++r) o[db][r] = 0.f;
    float m = -1e30f, l = 0.f;
    const int nt = 2 * qb + 2;
    const unsigned tilemask = nt >= 32 ? 0xffffffffu : ((1u << nt) - 1u);
    const bf16* Ub = U + (size_t)b * T * UP;
    attend<4>(X, o, m, l, qf, Ub + C_KA + 128 * h, Ub + C_VA + 128 * h, 128 * c, tilemask, qp, qw0, 0x7fffffff, 0xffffffffu, s2, 128 * qb);
    const float inv = 1.f / l;
    LAS float* xch = (LAS float*)(X.lds + L_XCH) + tq * 4096;
    if (c == 1) {
#pragma unroll
        for (int db = 0; db < 4; ++db)
#pragma unroll
            for (int r = 0; r < 16; ++r) xch[(db * 16 + r) * 64 + lane] = o[db][r] * inv;
    }
    __syncthreads();
    if (c == 0) {
        const float d1 = wave_sum(a.in[8][lane] * a.in[9][lane]), d2 = wave_sum(a.in[10][lane] * a.in[11][lane]);
        const float lam = __expf(d1) - __expf(d2) + LAM_INIT;
        float ss = 0.f;
#pragma unroll
        for (int db = 0; db < 4; ++db)
#pragma unroll
            for (int r = 0; r < 16; ++r) { const float v = o[db][r] * inv - lam * xch[(db * 16 + r) * 64 + lane]; o[db][r] = v; ss += v * v; }
        ss = xhalf_sum(ss);
        const float rstd = rsqrtf(ss * (1.f / 128.f) + NORM_EPS) * (1.f - LAM_INIT);
        const float* gsub = a.in[12];
#pragma unroll
        for (int db = 0; db < 4; ++db)
#pragma unroll
            for (int g4 = 0; g4 < 4; ++g4) {
                const int d0 = 32 * db + 8 * g4 + 4 * hi;
                const u32x2 zz = *(const u32x2*)(U + row * UP + C_ZA + 128 * h + d0);
                const f32x4 gv = *(const f32x4*)(gsub + d0);
                const float v0 = o[db][4 * g4 + 0] * rstd * gv.x * silu_f(bflo(zz.x)), v1 = o[db][4 * g4 + 1] * rstd * gv.y * silu_f(bfhi(zz.x));
                const float v2 = o[db][4 * g4 + 2] * rstd * gv.z * silu_f(bflo(zz.y)), v3 = o[db][4 * g4 + 3] * rstd * gv.w * silu_f(bfhi(zz.y));
                u32x2 ov; ov.x = pk2(v0, v1); ov.y = pk2(v2, v3);
                *(u32x2*)(CAT + row * DM + 128 * h + d0) = ov;
            }
    }
    __syncthreads();
}

__device__ __forceinline__ void compress_unit(const Ctx& X, const Args& a, int item) {
    const int kv = item & 1, rg = (item >> 1) & 3, b = item >> 3;
    const bf16* U = (const bf16*)(X.ws + WS_U);
    const bf16* W1t = (const bf16*)(X.ws + (kv ? WS_WV1 : WS_WK1)); const bf16* W2t = (const bf16*)(X.ws + (kv ? WS_WV2 : WS_WK2));
    bf16* outp = (bf16*)(X.ws + (kv ? WS_VCMP : WS_KCMP)) + (size_t)b * 128 * 128;
    const float* B1P = (const float*)(X.ws + WS_B1P);
    const int colbase = kv ? C_VC : C_KC;
    const int w = X.wave, lane = X.lane, hi = lane >> 5, q5 = lane & 31;
    const int cidx = 32 * rg + q5, cc = cidx < NCMP ? cidx : NCMP - 1;
    f32x16 g[4];
#pragma unroll
    for (int nb = 0; nb < 4; ++nb)
#pragma unroll
        for (int r = 0; r < 16; ++r) g[nb][r] = 0.f;
    for (int lt = 4 * w; lt < 4 * w + 4; ++lt) {
        const bf16* arow = U + ((size_t)b * T + 16 * cc + lt) * UP + colbase + 8 * hi;
        const bf16* wrow = W1t + (size_t)q5 * 4096 + lt * 128 + 8 * hi;
#pragma unroll 2
        for (int s = 0; s < 8; ++s) {
            const bf16x8 bfr = *(const bf16x8*)(arow + 16 * s);
#pragma unroll
            for (int nb = 0; nb < 4; ++nb) { const bf16x8 afr = *(const bf16x8*)(wrow + (size_t)nb * 32 * 4096 + 16 * s); g[nb] = MFMA32(afr, bfr, g[nb]); }
        }
    }
    LAS float* red = (LAS float*)X.lds;
    LAS float* bias = (LAS float*)(X.lds + 131072);
    LAS bf16* gact = (LAS bf16*)(X.lds + 131072 + 1024);
#pragma unroll
    for (int nb = 0; nb < 4; ++nb)
#pragma unroll
        for (int r = 0; r < 16; ++r) red[(w * 64 + nb * 16 + r) * 64 + lane] = g[nb][r];
    if (X.tid < 128) { float s = 0.f; for (int p = 0; p < 64; ++p) s += B1P[(kv * 64 + p) * 128 + X.tid]; bias[X.tid] = s; }
    __syncthreads();
#pragma unroll
    for (int ii = 0; ii < 8; ++ii) {
        const int idx = 8 * w + ii; float s = 0.f;
#pragma unroll
        for (int ww = 0; ww < 8; ++ww) s += red[(ww * 64 + idx) * 64 + lane];
        const int n = 32 * (idx >> 4) + crow(idx & 15, hi);
        const float v = gelu_tanh(s + bias[n]);
        gact[q5 * 136 + n] = (bf16)(pk2(v, 0.f) & 0xffffu);
    }
    __syncthreads();
    if (w < 4) {
        f32x16 acc;
#pragma unroll
        for (int r = 0; r < 16; ++r) acc[r] = 0.f;
#pragma unroll
        for (int s = 0; s < 8; ++s) {
            const bf16x8 bfr = *(LAS const bf16x8*)(gact + q5 * 136 + 16 * s + 8 * hi);
            const bf16x8 afr = *(const bf16x8*)(W2t + (size_t)(32 * w + q5) * 128 + 16 * s + 8 * hi);
            acc = MFMA32(afr, bfr, acc);
        }
#pragma unroll
        for (int g4 = 0; g4 < 4; ++g4) {
            const int n2 = 32 * w + 8 * g4 + 4 * hi;
            u32x2 ov; ov.x = pk2(acc[4 * g4 + 0], acc[4 * g4 + 1]); ov.y = pk2(acc[4 * g4 + 2], acc[4 * g4 + 3]);
            if (cidx >= NCMP) { ov.x = 0u; ov.y = 0u; }
            *(u32x2*)(outp + (size_t)cidx * 128 + n2) = ov;
        }
    }
    __syncthreads();
}

__device__ __forceinline__ void nsa_unit(const Ctx& X, const Args& a, int b, int i) {
    const bf16* U = (const bf16*)(X.ws + WS_U); bf16* CAT = (bf16*)(X.ws + WS_CAT); const float* G = (const float*)(X.ws + WS_GATES);
    const int w = X.wave, lane = X.lane, hi = lane >> 5, q5 = lane & 31, h = w >> 1, th = w & 1;
    const int qw0 = 64 * i + 32 * th, qp = qw0 + q5;
    const size_t row = (size_t)b * T + qp;
    bf16x8 qf[8];
#pragma unroll
    for (int s = 0; s < 8; ++s) qf[s] = *(const bf16x8*)(U + row * UP + C_QB + 128 * h + 16 * s + 8 * hi);
    const float s2 = exp2f(-2.f * (float)(h + 1)) * LOG2E;
    const float g0 = G[row * 16 + h], g1 = G[row * 16 + 4 + h], g2 = G[row * 16 + 8 + h];
    f32x4* accp = (f32x4*)((float*)(X.ws + WS_NSAACC) + (((size_t)X.bid * 8 + w) * 64 + lane) * 64);
    const bf16* Ub = U + (size_t)b * T * UP;
    LAS float* imp = (LAS float*)(X.lds + L_XCH);
    LAS unsigned* selm = (LAS unsigned*)(X.lds + L_MISC + 256);
    const float NEGINF = -__builtin_inff();
    const int koff = q5 * KSTR + hi * 16;
    const int voff = KT_BYTES + (4 * hi + ((lane & 15) >> 2)) * VSTR + (16 * ((lane >> 4) & 1) + 4 * (lane & 3)) * 2;
#ifndef NSA_PARTS
#define NSA_PARTS 7
#endif
    if (NSA_PARTS & 1) {
    f32x16 A[4];
#pragma unroll
    for (int db = 0; db < 4; ++db)
#pragma unroll
        for (int r = 0; r < 16; ++r) A[db][r] = 0.f;
    {
        const int nct = (4 * i + 3 + 63) >> 6;
        const bf16* Kc = (const bf16*)(X.ws + WS_KCMP) + (size_t)b * 128 * 128; const bf16* Vc = (const bf16*)(X.ws + WS_VCMP) + (size_t)b * 128 * 128;
        u32x4 sr[4];
        stage_load(sr, Kc, Vc, 128, X.tid); stage_store(X.lds + L_BUF0, sr, X.tid);
        if (nct > 1) { stage_load(sr, Kc + 64 * 128, Vc + 64 * 128, 128, X.tid); stage_store(X.lds + L_BUF1, sr, X.tid); }
        __syncthreads();
        f32x16 p[4];
        qk_tile<8>(p[0], p[1], X.lds + L_BUF0 + koff, qf);
        if (nct > 1) qk_tile<8>(p[2], p[3], X.lds + L_BUF1 + koff, qf);
        else {
#pragma unroll
            for (int r = 0; r < 16; ++r) { p[2][r] = 0.f; p[3][r] = 0.f; }
        }
        float mx = NEGINF;
        int lim = qp - 64 * hi - 31; float bb0 = s2 * (float)(64 * hi + 31 - 64 * i);
        asm volatile("" : "+v"(lim), "+v"(bb0));
#pragma unroll
        for (int hh = 0; hh < 4; ++hh)
#pragma unroll
            for (int r = 0; r < 16; ++r) { const int CC = 16 * (32 * hh + (r & 3) + 8 * (r >> 2));
                const bool ok = (CC <= lim) && (hh < 2 * nct);
                const float t = ok ? p[hh][r] + fmaf(s2, (float)CC, bb0) : NEGINF; p[hh][r] = t; mx = fmaxf(mx, t); }
        mx = xhalf_max(mx);
        const float mm = (mx == NEGINF) ? 0.f : mx;
        float sum = 0.f;
#pragma unroll
        for (int hh = 0; hh < 4; ++hh)
#pragma unroll
            for (int r = 0; r < 16; ++r) { const float e = __builtin_amdgcn_exp2f(p[hh][r] - mm); p[hh][r] = e; sum += e; }
        sum = xhalf_sum(sum);
        const float inv = sum > 0.f ? 1.f / sum : 0.f;
        float av[16], bv[16];
#pragma unroll
        for (int hh = 0; hh < 4; ++hh)
#pragma unroll
            for (int g4 = 0; g4 < 4; ++g4) { const float t3 = 0.5f * p[hh][4 * g4 + 3] * inv;
                av[hh * 4 + g4] = (p[hh][4 * g4] + p[hh][4 * g4 + 1] + p[hh][4 * g4 + 2]) * inv + t3; bv[hh * 4 + g4] = t3; }
#pragma unroll
        for (int idx = 0; idx < 16; ++idx) bv[idx] = __shfl_xor(bv[idx], 32);
#pragma unroll
        for (int idx = 0; idx < 16; ++idx) { const float add = hi ? bv[idx] : (idx > 0 ? bv[idx > 0 ? idx - 1 : 0] : 0.f);
            imp[(h * 64 + 32 * th + q5) * 33 + 2 * idx + hi] = av[idx] + add; }
        const float sc = inv * g0;
#pragma unroll
        for (int hh = 0; hh < 4; ++hh) p[hh] = p[hh] * sc;
        pv_tile(A, X.lds + L_BUF0 + voff, pack8(p[0], 0), pack8(p[0], 8), pack8(p[1], 0), pack8(p[1], 8));
        if (nct > 1) pv_tile(A, X.lds + L_BUF1 + voff, pack8(p[2], 0), pack8(p[2], 8), pack8(p[3], 0), pack8(p[3], 8));
        __syncthreads();
        if (w == 0) {
            unsigned mask;
            if (i + 1 <= 8) mask = (1u << (i + 1)) - 1u;
            else {
                LAS float* s0 = imp + lane * 33;
                for (int j = 1; j < i; ++j) s0[j] = ((s0[j] + imp[(64 + lane) * 33 + j]) + imp[(128 + lane) * 33 + j]) + imp[(192 + lane) * 33 + j];
                mask = 1u | (1u << i);
                for (int k = 0; k < 6; ++k) { float best = NEGINF; int bj = 1;
                    for (int j = 1; j < i; ++j) { const float s = s0[j]; if (!((mask >> j) & 1u) && s > best) { best = s; bj = j; } }
                    mask |= 1u << bj; }
            }
            selm[lane] = mask;
            unsigned um = mask;
#pragma unroll
            for (int o = 1; o < 64; o <<= 1) um |= __shfl_xor(um, o);
            if (lane == 0) selm[64] = um;
        }
        __syncthreads();
    }
#pragma unroll
    for (int db = 0; db < 4; ++db)
#pragma unroll
        for (int g4 = 0; g4 < 4; ++g4) accp[db * 4 + g4] = (f32x4){A[db][4 * g4], A[db][4 * g4 + 1], A[db][4 * g4 + 2], A[db][4 * g4 + 3]};
    }
    f32x16 o[4]; float m, l;
    if (NSA_PARTS & 2) {
        const unsigned uni = selm[64], mybits = selm[32 * th + q5];
#pragma unroll
        for (int db = 0; db < 4; ++db)
#pragma unroll
            for (int r = 0; r < 16; ++r) o[db][r] = 0.f;
        m = -1e30f; l = 0.f;
        attend<8>(X, o, m, l, qf, Ub + C_KS, Ub + C_VS, 0, uni, qp, qw0, 0x7fffffff, mybits, s2, 64 * i);
        const float sc = g1 / l;
#pragma unroll
        for (int db = 0; db < 4; ++db)
#pragma unroll
            for (int g4 = 0; g4 < 4; ++g4) { f32x4 v = accp[db * 4 + g4];
                v.x += o[db][4 * g4] * sc; v.y += o[db][4 * g4 + 1] * sc; v.z += o[db][4 * g4 + 2] * sc; v.w += o[db][4 * g4 + 3] * sc; accp[db * 4 + g4] = v; }
    }
    if (NSA_PARTS & 4) {
        const int j0 = i >= 4 ? i - 4 : 0;
        const unsigned wmask = (i >= 31 ? 0xffffffffu : ((1u << (i + 1)) - 1u)) & ~((1u << j0) - 1u);
#pragma unroll
        for (int db = 0; db < 4; ++db)
#pragma unroll
            for (int r = 0; r < 16; ++r) o[db][r] = 0.f;
        m = -1e30f; l = 0.f;
        attend<8>(X, o, m, l, qf, Ub + C_KW, Ub + C_VW, 0, wmask, qp, qw0, 256, 0xffffffffu, s2, 64 * i);
        const float sc = g2 / l;
#pragma unroll
        for (int db = 0; db < 4; ++db)
#pragma unroll
            for (int g4 = 0; g4 < 4; ++g4) { const f32x4 v = accp[db * 4 + g4];
                o[db][4 * g4] = v.x + o[db][4 * g4] * sc; o[db][4 * g4 + 1] = v.y + o[db][4 * g4 + 1] * sc; o[db][4 * g4 + 2] = v.z + o[db][4 * g4 + 2] * sc; o[db][4 * g4 + 3] = v.w + o[db][4 * g4 + 3] * sc; }
    }
#pragma unroll
    for (int db = 0; db < 4; ++db)
#pragma unroll
        for (int g4 = 0; g4 < 4; ++g4) {
            const int d0 = 32 * db + 8 * g4 + 4 * hi;
            const u32x2 zz = *(const u32x2*)(U + row * UP + C_ZB + 128 * h + d0);
            const float v0 = o[db][4 * g4 + 0] * silu_f(bflo(zz.x)), v1 = o[db][4 * g4 + 1] * silu_f(bfhi(zz.x));
            const float v2 = o[db][4 * g4 + 2] * silu_f(bflo(zz.y)), v3 = o[db][4 * g4 + 3] * silu_f(bfhi(zz.y));
            u32x2 ov; ov.x = pk2(v0, v1); ov.y = pk2(v2, v3);
            *(u32x2*)(CAT + row * DM + 512 + 128 * h + d0) = ov;
        }
}

__device__ __forceinline__ int q_next(const Ctx& X, unsigned* ctr) {
    LAS int* slot = (LAS int*)(X.lds + L_MISC);
    __syncthreads();
    if (X.tid == 0) *slot = (int)atomicAdd(ctr, 1u) + X.G;
    __syncthreads();
    return *slot;
}

__global__ void __launch_bounds__(512, 2) fwd_kernel(Args a) {
    extern __shared__ __attribute__((aligned(16))) unsigned char lds_raw[];
    Ctx X;
    X.lds = (LAS unsigned char*)lds_raw; X.ws = a.ws;
    X.tid = threadIdx.x; X.lane = X.tid & 63; X.wave = __builtin_amdgcn_readfirstlane(X.tid >> 6); X.G = gridDim.x; X.bid = blockIdx.x;
    cg::grid_group grid = cg::this_grid();
    const int lo = a.ph_lo, hi = a.ph_hi;
#ifndef PH_MASK
#define PH_MASK 0x7f
#endif
#define IN(k) (((PH_MASK >> (k)) & 1) && lo <= (k) && (k) < hi)
#define SEAM(k) do { if (IN(k) && IN((k) + 1)) grid.sync(); } while (0)
    if (IN(0)) p0_prologue(X, a);
    SEAM(0);
    if (IN(1)) p1_norm(X, a);
    SEAM(1);
    if (IN(2)) {
        pg8::Gemm g{(const pg8::bf16_t*)(X.ws + WS_H), (const pg8::bf16_t*)(X.ws + WS_WIN), M, UP, 1024};
        pg8::StaticOrder S; S.init(M, UP, X.G, X.bid);
        pg8::EpiBf16<0> E{(pg8::bf16_t*)(X.ws + WS_U), UP, nullptr, 0, 0, 1.f};
        pg8::gemm_phase<pg8::EpiBf16<0>, pg8::StaticOrder, true, true>(X.lds, g, S, E);
    }
    SEAM(2);
    if (IN(3)) {
        unsigned* ctr = (unsigned*)(X.ws + WS_CTL) + CW_Q3;
        constexpr int NITEMS = 128 + 1024;
        int it = X.bid;
        for (; it < 128; it = q_next(X, ctr)) compress_unit(X, a, it);
        for (; it < NITEMS; it = q_next(X, ctr)) { const int u = it - 128, qb = 15 - (u >> 6), bh = u & 63; diff_unit(X, a, bh >> 2, bh & 3, qb); }
    }
    SEAM(3);
    if (IN(4)) {
        unsigned* ctr = (unsigned*)(X.ws + WS_CTL) + CW_Q4;
        for (int it = X.bid; it < 512; it = q_next(X, ctr)) { const int i = 31 - (it >> 4), b = it & 15; nsa_unit(X, a, b, i); }
    }
    SEAM(4);
    if (IN(5)) {
        pg8::Gemm g{(const pg8::bf16_t*)(X.ws + WS_CAT), (const pg8::bf16_t*)(X.ws + WS_WOUT), M, DM, 1024};
        pg8::StaticOrder S; S.init(M, DM, X.G, X.bid);
        pg8::EpiBf16<0> E{(pg8::bf16_t*)(X.ws + WS_Y), DM, nullptr, 0, 0, 1.f};
        pg8::gemm_phase<pg8::EpiBf16<0>, pg8::StaticOrder, true, true>(X.lds, g, S, E);
    }
    SEAM(5);
    if (IN(6)) p6_final(X, a);
#undef IN
#undef SEAM
}

#ifndef N_LAUNCHES
#define N_LAUNCHES 1
#endif
extern "C" void kernel_launch(void* const* d_in, const int* in_sizes, int n_in, void* d_out, int out_size, void* d_ws, size_t ws_size, hipStream_t stream) {
    static int grid = 0;
    if (grid == 0) {
        if (n_in != 18 || in_sizes[0] != M * DM || out_size != M * DM || ws_size < WS_END) { fprintf(stderr, "kernel_launch: unexpected shapes (n_in %d, in0 %d, out %d, ws %zu)\n", n_in, n_in > 0 ? in_sizes[0] : -1, out_size, ws_size); grid = -1; return; }
        int dev = 0, cus = 0, per_cu = 0;
        (void)hipGetDevice(&dev); (void)hipDeviceGetAttribute(&cus, hipDeviceAttributeMultiprocessorCount, dev);
        if (hipFuncSetAttribute((const void*)fwd_kernel, hipFuncAttributeMaxDynamicSharedMemorySize, LDS_BYTES) != hipSuccess) { fprintf(stderr, "kernel_launch: hipFuncSetAttribute failed\n"); grid = -1; return; }
        if (hipOccupancyMaxActiveBlocksPerMultiprocessor(&per_cu, (const void*)fwd_kernel, 512, LDS_BYTES) != hipSuccess || per_cu < 1) { fprintf(stderr, "kernel_launch: occupancy query says %d blocks/CU\n", per_cu); per_cu = 1; }
        (void)hipGetLastError();
        grid = cus;
        fprintf(stderr, "kernel_launch: grid %d (cus %d, per_cu %d)\n", grid, cus, per_cu);
    }
    if (grid < 0) return;
    (void)hipMemsetAsync((char*)d_ws + WS_CTL, 0, CTL_BYTES, stream);
    Args a{};
    for (int i = 0; i < 18; ++i) a.in[i] = (const float*)d_in[i];
    a.out = (float*)d_out; a.ws = (unsigned char*)d_ws;
    if (N_LAUNCHES == 1) {
        a.ph_lo = 0; a.ph_hi = 7;
        void* args[] = {&a};
        hipError_t e = hipLaunchCooperativeKernel((const void*)fwd_kernel, dim3(grid), dim3(512), args, LDS_BYTES, stream);
        if (e != hipSuccess) fprintf(stderr, "cooperative launch failed: %s (grid %d)\n", hipGetErrorString(e), grid);
    } else {
        for (int p = 0; p < 7; ++p) { a.ph_lo = p; a.ph_hi = p + 1; hipLaunchKernelGGL(fwd_kernel, dim3(grid), dim3(512), LDS_BYTES, stream, a); }
    }
}
```

```cpp
#include <hip/hip_runtime.h>
#include <hip/hip_cooperative_groups.h>
#include <cstdio>
#include <cstdint>
namespace cg = cooperative_groups;

namespace pg8 {
#define PG8_LAS __attribute__((address_space(3)))
typedef unsigned short bf16_t;
typedef short bf16x8 __attribute__((ext_vector_type(8)));
typedef float f32x4 __attribute__((ext_vector_type(4)));
typedef unsigned u32x4 __attribute__((ext_vector_type(4)));
constexpr int BM = 256, BK = 64, HALF = 128, HTB = HALF * BK * 2  , STAGE_BYTES = 8 * HTB, NXCD = 8, WGM = 8;

__host__ __device__ __forceinline__ int lds_byte(int r, int c) { const int st = (r >> 4) * 2 + (c >> 5), rr = r & 15, cc = c & 31, ob = rr * 64 + cc * 2; return st * 1024 + (ob ^ (((ob >> 9) & 1) << 5)); }
__host__ __device__ __forceinline__ void stage_rc(int b, int& R, int& C) { const int st = b / 1024, sb = b % 1024, swz = sb ^ (((sb >> 9) & 1) << 5); R = (st >> 1) * 16 + swz / 64; C = (st & 1) * 32 + (swz % 64) / 2; }
__host__ __device__ __forceinline__ int perm32(int rho) { const int n = rho >> 4, i = rho & 15; return 8 * (i >> 2) + 4 * n + (i & 3); }

struct Unit { int pm, pn; };
struct Gemm { const bf16_t* A; const bf16_t* Bt; int M, N, K; };

struct StaticOrder {
    int nM, nN, nwg, G, c;
    __host__ __device__ void init(int M, int N, int G_, int c_) { nM = M / BM; nN = N / BM; nwg = nM * nN; G = G_; c = c_; }
    __host__ __device__ bool next(int i, Unit& u) const {
        const long L = (long)i * G + c; if (L >= nwg) return false;
        int wgid = (int)L; { const int q = nwg / NXCD, r = nwg % NXCD, xcd = wgid % NXCD, off = wgid / NXCD; wgid = (xcd < r ? xcd * (q + 1) : r * (q + 1) + (xcd - r) * q) + off; }
        const int nig = WGM * nN, gid = wgid / nig, fm = gid * WGM, gsz = (nM - fm) < WGM ? (nM - fm) : WGM;
        u.pm = fm + ((wgid % nig) % gsz); u.pn = (wgid % nig) / gsz; return true;
    }
    __device__ __forceinline__ void a_ready(const Unit&) const {}
    __device__ __forceinline__ void done(const Unit&) const {}
};

__device__ __forceinline__ unsigned cvt_pk_bf16(float lo, float hi) { unsigned r; asm volatile("v_cvt_pk_bf16_f32 %0, %1, %2" : "=v"(r) : "v"(lo), "v"(hi)); return r; }
typedef float f32x2 __attribute__((ext_vector_type(2)));
__device__ __forceinline__ f32x2 gelu_pk(f32x2 v) {
    const f32x2 av = __builtin_elementwise_abs(v), d = av * 0.2316418882f + 1.0f;
    f32x2 t; t.x = __builtin_amdgcn_rcpf(d.x); t.y = __builtin_amdgcn_rcpf(d.y);
    f32x2 q = t * 0.5307027145f + (-0.7265760135f); q = q * t + 0.7107068705f; q = q * t + (-0.142248368f); q = q * t + 0.127414796f; q = q * t;
    const f32x2 s = (v * v) * (-0.72134752044f);
    f32x2 e; e.x = __builtin_amdgcn_exp2f(s.x); e.y = __builtin_amdgcn_exp2f(s.y);
    const f32x2 m = v * (q * e), r = v - m;
    f32x2 o; o.x = v.x < 0.f ? m.x : r.x; o.y = v.y < 0.f ? m.y : r.y; return o;
}

template <int ACT  > struct EpiBf16 {
    static constexpr bool PERM = true, AFTER_DRAIN = false; static_assert(ACT == 0 || ACT == 1, "EpiBf16: ACT is 0 (none) or 1 (gelu_pk)");
    bf16_t* O; int ldc; const float* bias; int split_cols; size_t split_stride; float scale0;
    __device__ __forceinline__ void operator()(const f32x4 (&acc)[2][2][4][2], const Unit& u, int wr, int wc, int fr, int fq) const {
        const int row0 = u.pm * BM + wr * 64 + fr; int colt = u.pn * BM; bf16_t* base = O;
        float sc = 1.f; if (split_cols) { const int t = colt / split_cols; base += (size_t)t * split_stride; colt -= t * split_cols; if (t == 0) sc = scale0; }
        const int col0 = colt + wc * 32 + 8 * fq, bcol0 = u.pn * BM + wc * 32 + 8 * fq;
        f32x4 bv[2][2];
#pragma unroll
        for (int bj = 0; bj < 2; ++bj)
#pragma unroll
            for (int n = 0; n < 2; ++n) bv[bj][n] = bias ? *(const f32x4*)(bias + bcol0 + bj * HALF + 4 * n) : (f32x4){0.f, 0.f, 0.f, 0.f};
#pragma unroll
        for (int ai = 0; ai < 2; ++ai)
#pragma unroll
            for (int m = 0; m < 4; ++m) { bf16_t* rowp = base + (size_t)(row0 + ai * HALF + m * 16) * ldc + col0;
#pragma unroll
                for (int bj = 0; bj < 2; ++bj) { f32x4 v0 = acc[ai][bj][m][0] + bv[bj][0], v1 = acc[ai][bj][m][1] + bv[bj][1];
                    if (ACT == 1) { f32x2 a = gelu_pk((f32x2){v0[0], v0[1]}), b = gelu_pk((f32x2){v0[2], v0[3]}), c = gelu_pk((f32x2){v1[0], v1[1]}), d = gelu_pk((f32x2){v1[2], v1[3]});
                        v0 = (f32x4){a.x, a.y, b.x, b.y}; v1 = (f32x4){c.x, c.y, d.x, d.y}; }
                    v0 = v0 * sc; v1 = v1 * sc; u32x4 w; w.x = cvt_pk_bf16(v0[0], v0[1]); w.y = cvt_pk_bf16(v0[2], v0[3]); w.z = cvt_pk_bf16(v1[0], v1[1]); w.w = cvt_pk_bf16(v1[2], v1[3]);
                    *(u32x4*)(rowp + bj * HALF) = w; } }
    }
};

template <class Epi, class Sched, bool ALIGN_EPI = false, bool SP2 = false>
__device__ __forceinline__ void gemm_phase(PG8_LAS unsigned char* lds, const Gemm g, const Sched& S, const Epi& E) {
    const int tid = threadIdx.x, wid = __builtin_amdgcn_readfirstlane(tid >> 6), lane = tid & 63, wr = wid >> 2, wc = wid & 3, fr = lane & 15, fq = lane >> 4;
    const int K = g.K, nt = K / BK;
    unsigned voffA[2], voffB[2];
#pragma unroll
    for (int i = 0; i < 2; ++i) { int R, C; stage_rc(tid * 16 + i * 8192, R, C); const int Rb = Epi::PERM ? ((R & ~31) + perm32(R & 31)) : R;
        voffA[i] = (unsigned)(R * K + C) * 2u; voffB[i] = (unsigned)(Rb * K + C) * 2u; }
    const size_t kstep = (size_t)(BK * 2);
    const size_t hstep = (size_t)HALF * K * 2;
    const size_t tstep = 2 * hstep;
    const unsigned ldsw = (unsigned)wid * 1024u;
    const int aoff = lds_byte(wr * 64 + fr, fq * 8), boff = lds_byte(wc * 32 + fr, fq * 8);
#define PG8_SA(b, h) (((b) * 2 + (h)) * HTB)
#define PG8_SB(b, h) ((4 + (b) * 2 + (h)) * HTB)
#define PG8_STAGE(bufoff, gbase, voff) do { _Pragma("unroll") for (int _i = 0; _i < 2; ++_i) \
        __builtin_amdgcn_global_load_lds((const unsigned*)((const char*)(gbase) + (voff)[_i]), (PG8_LAS unsigned*)(lds + (bufoff) + ldsw + _i * 8192), 16, 0, 0); } while (0)
#define PG8_LDA(dst, b, h) do { _Pragma("unroll") for (int m = 0; m < 4; ++m) _Pragma("unroll") for (int k = 0; k < 2; ++k) dst[m][k] = *(const PG8_LAS bf16x8*)(lds + PG8_SA(b, h) + aoff + m * 2048 + k * 1024); } while (0)
#define PG8_LDB(dst, b, h) do { _Pragma("unroll") for (int n = 0; n < 2; ++n) _Pragma("unroll") for (int k = 0; k < 2; ++k) dst[n][k] = *(const PG8_LAS bf16x8*)(lds + PG8_SB(b, h) + boff + n * 2048 + k * 1024); } while (0)
#define PG8_MMA(ai, bj, At, Bt) do { __builtin_amdgcn_s_setprio(1); _Pragma("unroll") for (int m = 0; m < 4; ++m) _Pragma("unroll") for (int n = 0; n < 2; ++n) _Pragma("unroll") for (int k = 0; k < 2; ++k) \
        acc[ai][bj][m][n] = __builtin_amdgcn_mfma_f32_16x16x32_bf16(Bt[n][k], At[m][k], acc[ai][bj][m][n], 0, 0, 0); __builtin_amdgcn_s_setprio(0); } while (0)
#define PG8_WAIT_V(n) asm volatile("s_waitcnt vmcnt(" #n ")" ::: "memory")
#define PG8_WAIT_L(n) asm volatile("s_waitcnt lgkmcnt(" #n ")" ::: "memory")
#define PG8_BAR __builtin_amdgcn_s_barrier()
#define PG8_SCHED __builtin_amdgcn_sched_barrier(0)
    Unit cur, nxt; int ui = 0;
    if (!S.next(0, cur)) return;
    f32x4 acc[2][2][4][2];
#pragma unroll
    for (int a = 0; a < 2; ++a)
#pragma unroll
        for (int b = 0; b < 2; ++b)
#pragma unroll
            for (int m = 0; m < 4; ++m)
#pragma unroll
                for (int n = 0; n < 2; ++n) acc[a][b][m][n] = (f32x4){0.f, 0.f, 0.f, 0.f};
    bf16x8 At[4][2], B0[2][2], B1[2][2];
    const char* cA = (const char*)g.A + (size_t)cur.pm * tstep; const char* cB = (const char*)g.Bt + (size_t)cur.pn * tstep;
    S.a_ready(cur);
    if constexpr (SP2) {
        PG8_STAGE(PG8_SB(0, 0), cB, voffB); PG8_STAGE(PG8_SB(0, 1), cB + hstep, voffB); PG8_STAGE(PG8_SA(0, 0), cA, voffA); PG8_STAGE(PG8_SA(0, 1), cA + hstep, voffA);
        if (wr == 1) PG8_BAR;
        PG8_WAIT_V(2); PG8_BAR;
        PG8_STAGE(PG8_SB(1, 0), cB + kstep, voffB); PG8_STAGE(PG8_SA(1, 0), cA + kstep, voffA); PG8_STAGE(PG8_SB(1, 1), cB + hstep + kstep, voffB);
        PG8_WAIT_V(6); PG8_BAR;
    } else {
        PG8_STAGE(PG8_SB(0, 0), cB, voffB); PG8_STAGE(PG8_SA(0, 0), cA, voffA); PG8_STAGE(PG8_SB(0, 1), cB + hstep, voffB); PG8_STAGE(PG8_SA(0, 1), cA + hstep, voffA);
        if (wr == 1) PG8_BAR;
        PG8_WAIT_V(4); PG8_BAR;
        PG8_STAGE(PG8_SB(1, 0), cB + kstep, voffB); PG8_STAGE(PG8_SA(1, 0), cA + kstep, voffA); PG8_STAGE(PG8_SB(1, 1), cB + hstep + kstep, voffB);
        PG8_WAIT_V(6); PG8_BAR;
    }
    for (;;) {
        const bool has_next = S.next(ui + 1, nxt);
        const char* nA = has_next ? (const char*)g.A + (size_t)nxt.pm * tstep : cA; const char* nB = has_next ? (const char*)g.Bt + (size_t)nxt.pn * tstep : cB;
        for (int t = 0; t < nt; t += 2) {
            const bool last = (t == nt - 2);
            const char* a1 = cA + (size_t)(t + 1) * kstep;
            const char* a2 = last ? nA : cA + (size_t)(t + 2) * kstep; const char* b2 = last ? nB : cB + (size_t)(t + 2) * kstep;
            const char* a3 = a2 + kstep; const char* b3 = b2 + kstep;
            if (last && has_next) S.a_ready(nxt);
            if constexpr (SP2) {
            PG8_LDB(B0, 0, 0); PG8_LDB(B1, 0, 1); PG8_SCHED; PG8_LDA(At, 0, 0); PG8_STAGE(PG8_SA(1, 1), a1 + hstep, voffA);
            PG8_WAIT_V(8); PG8_WAIT_L(0); PG8_BAR; PG8_MMA(0, 0, At, B0); PG8_MMA(0, 1, At, B1); PG8_BAR; PG8_SCHED;
            PG8_LDA(At, 0, 1); PG8_STAGE(PG8_SB(0, 0), b2, voffB); PG8_STAGE(PG8_SB(0, 1), b2 + hstep, voffB); PG8_STAGE(PG8_SA(0, 0), a2, voffA);
            PG8_WAIT_V(8); PG8_WAIT_L(0); PG8_BAR; PG8_MMA(1, 0, At, B0); PG8_MMA(1, 1, At, B1); PG8_BAR; PG8_SCHED;
            PG8_LDB(B0, 1, 0); PG8_LDB(B1, 1, 1); PG8_SCHED; PG8_LDA(At, 1, 0); PG8_STAGE(PG8_SA(0, 1), a2 + hstep, voffA);
            PG8_WAIT_V(8); PG8_WAIT_L(0); PG8_BAR; PG8_MMA(0, 0, At, B0); PG8_MMA(0, 1, At, B1); PG8_BAR; PG8_SCHED;
            PG8_LDA(At, 1, 1); PG8_STAGE(PG8_SB(1, 0), b3, voffB); PG8_STAGE(PG8_SB(1, 1), b3 + hstep, voffB); PG8_STAGE(PG8_SA(1, 0), a3, voffA);
            PG8_WAIT_V(8); PG8_WAIT_L(0); PG8_BAR; PG8_MMA(1, 0, At, B0); PG8_MMA(1, 1, At, B1); PG8_BAR; PG8_SCHED;
            } else {
            PG8_LDB(B0, 0, 0); PG8_SCHED; PG8_LDA(At, 0, 0); PG8_STAGE(PG8_SA(1, 1), a1 + hstep, voffA);
            PG8_WAIT_L(8); PG8_BAR; PG8_WAIT_L(0); PG8_MMA(0, 0, At, B0); PG8_BAR; PG8_SCHED;
            PG8_LDB(B1, 0, 1); PG8_STAGE(PG8_SB(0, 0), b2, voffB);
            PG8_BAR; PG8_WAIT_L(0); PG8_MMA(0, 1, At, B1); PG8_BAR;
            PG8_LDA(At, 0, 1); PG8_STAGE(PG8_SA(0, 0), a2, voffA);
            PG8_BAR; PG8_WAIT_L(0); PG8_MMA(1, 0, At, B0); PG8_BAR; PG8_SCHED;
            PG8_STAGE(PG8_SB(0, 1), b2 + hstep, voffB);
            PG8_WAIT_V(6); PG8_BAR; PG8_MMA(1, 1, At, B1); PG8_BAR;
            PG8_LDB(B0, 1, 0); PG8_SCHED; PG8_LDA(At, 1, 0); PG8_STAGE(PG8_SA(0, 1), a2 + hstep, voffA);
            PG8_WAIT_L(8); PG8_BAR; PG8_WAIT_L(0); PG8_MMA(0, 0, At, B0); PG8_BAR; PG8_SCHED;
            PG8_LDB(B1, 1, 1); PG8_STAGE(PG8_SB(1, 0), b3, voffB);
            PG8_BAR; PG8_WAIT_L(0); PG8_MMA(0, 1, At, B1); PG8_BAR;
            PG8_LDA(At, 1, 1); PG8_STAGE(PG8_SA(1, 0), a3, voffA);
            PG8_BAR; PG8_WAIT_L(0); PG8_MMA(1, 0, At, B0); PG8_BAR; PG8_SCHED;
            PG8_STAGE(PG8_SB(1, 1), b3 + hstep, voffB);
            PG8_WAIT_V(6); PG8_BAR; PG8_MMA(1, 1, At, B1); PG8_BAR;
            }
        }
        if constexpr (ALIGN_EPI) { if (wr == 0) PG8_BAR; }
        if constexpr (!Epi::AFTER_DRAIN) { E(acc, cur, wr, wc, fr, fq); S.done(cur); }
        if (!has_next) break;
#pragma unroll
        for (int a = 0; a < 2; ++a)
#pragma unroll
            for (int b = 0; b < 2; ++b)
#pragma unroll
                for (int m = 0; m < 4; ++m)
#pragma unroll
                    for (int n = 0; n < 2; ++n) acc[a][b][m][n] = (f32x4){0.f, 0.f, 0.f, 0.f};
        cur = nxt; cA = nA; cB = nB; ++ui;
        if constexpr (ALIGN_EPI) { if (wr == 1) PG8_BAR; }
    }
    PG8_WAIT_V(0);
    if constexpr (!ALIGN_EPI) { if (wr == 0) PG8_BAR; }
    PG8_BAR;
    if constexpr (Epi::AFTER_DRAIN) { E.fused(acc, cur, wr, wc, fr, fq, lds, wid, lane); S.done(cur); }
#undef PG8_SA
#undef PG8_SB
#undef PG8_STAGE
#undef PG8_LDA
#undef PG8_LDB
#undef PG8_MMA
#undef PG8_WAIT_V
#undef PG8_WAIT_L
#undef PG8_BAR
#undef PG8_SCHED
}
}


constexpr int NB = 16, T = 2048, DM = 1024, M = NB * T;
constexpr int UP = 3840;
constexpr int C_QA = 0, C_KA = 512, C_VA = 1024, C_ZA = 1536, C_QB = 2048, C_KC = 2560, C_VC = 2688, C_KS = 2816, C_VS = 2944, C_KW = 3072, C_VW = 3200, C_ZB = 3328;
constexpr int DIN_SRC = 3852, GATE_SRC = 3328;
constexpr int NCMP = 127;
constexpr float LOG2E = 1.4426950408889634f;
constexpr float QA_SCALE = 0.125f * LOG2E;
constexpr float QB_SCALE = 0.08838834764831845f * LOG2E;
constexpr float NORM_EPS = 1e-6f;
constexpr float LAM_INIT = 0.2f;

constexpr size_t MiB = 1u << 20;
constexpr size_t WS_CTL = 0;
constexpr size_t WS_WIN = 2 * MiB;
constexpr size_t WS_WOUT = 10 * MiB;
constexpr size_t WS_WK1 = 12 * MiB, WS_WV1 = 13 * MiB;
constexpr size_t WS_WK2 = 14 * MiB, WS_WV2 = 14 * MiB + 65536;
constexpr size_t WS_MOD = 15 * MiB;
constexpr size_t WS_B1P = 15 * MiB + 524288;
constexpr size_t WS_KCMP = 16 * MiB, WS_VCMP = 16 * MiB + 524288;
constexpr size_t WS_GATES = 18 * MiB;
constexpr size_t WS_H = 32 * MiB;
constexpr size_t WS_Y = 32 * MiB;
constexpr size_t WS_U = 96 * MiB;
constexpr size_t WS_CAT = 336 * MiB;
constexpr size_t WS_NSAACC = 400 * MiB;
constexpr size_t WS_END = 432 * MiB;
constexpr int CTL_BYTES = 4096 + 16384;
constexpr int CW_BAR = 1024;
constexpr int CW_Q3 = 0, CW_Q4 = 64;

constexpr int LDS_BYTES = 147456;
constexpr int KSTR = 272, VSTR = 320;
constexpr int KT_BYTES = 64 * KSTR, VT_BYTES = 64 * VSTR, BUF_BYTES = KT_BYTES + VT_BYTES;
constexpr int L_BUF0 = 0, L_BUF1 = BUF_BYTES, L_XCH = 77824, L_MISC = 143360;
static_assert(2 * BUF_BYTES <= L_XCH && L_XCH + 65536 <= L_MISC && L_MISC + 4096 <= LDS_BYTES, "LDS map");

#define LAS __attribute__((address_space(3)))
typedef unsigned short bf16;
typedef short bf16x8 __attribute__((ext_vector_type(8)));
typedef short s16x4 __attribute__((ext_vector_type(4)));
typedef float f32x4 __attribute__((ext_vector_type(4)));
typedef float f32x16 __attribute__((ext_vector_type(16)));
typedef unsigned u32x4 __attribute__((ext_vector_type(4)));
typedef unsigned u32x2 __attribute__((ext_vector_type(2)));
typedef float f32x2_t __attribute__((ext_vector_type(2)));
typedef __bf16 bf16x2_t __attribute__((ext_vector_type(2)));

__device__ __forceinline__ unsigned pk2(float lo, float hi) { f32x2_t v = {lo, hi}; bf16x2_t b = __builtin_convertvector(v, bf16x2_t); return __builtin_bit_cast(unsigned, b); }
__device__ __forceinline__ float bf2f(unsigned short u) { return __uint_as_float((unsigned)u << 16); }
__device__ __forceinline__ float bflo(unsigned w) { return __uint_as_float(w << 16); }
__device__ __forceinline__ float bfhi(unsigned w) { return __uint_as_float(w & 0xffff0000u); }
__device__ __forceinline__ float wave_sum(float v) {
#pragma unroll
    for (int o = 1; o < 64; o <<= 1) v += __shfl_xor(v, o);
    return v;
}
__device__ __forceinline__ float xhalf_max(float v) { auto rr = __builtin_amdgcn_permlane32_swap(__float_as_uint(v), __float_as_uint(v), false, false); return fmaxf(__uint_as_float(rr[0]), __uint_as_float(rr[1])); }
__device__ __forceinline__ float xhalf_sum(float v) { auto rr = __builtin_amdgcn_permlane32_swap(__float_as_uint(v), __float_as_uint(v), false, false); return __uint_as_float(rr[0]) + __uint_as_float(rr[1]); }
__device__ __forceinline__ float silu_f(float v) { return v / (1.f + __expf(-v)); }
__device__ __forceinline__ float sigmoid_f(float v) { return 1.f / (1.f + __expf(-v)); }
__device__ __forceinline__ float gelu_tanh(float x) { const float u = 0.7978845608028654f * (x + 0.044715f * x * x * x); const float e = __expf(2.f * u); const float th = 1.f - 2.f / (1.f + e); return 0.5f * x * (1.f + th); }
__device__ __forceinline__ int crow(int r, int hi) { return (r & 3) + 8 * (r >> 2) + 4 * hi; }
__device__ __forceinline__ bf16x8 pack8(const f32x16& p, int b0) {
    u32x4 w = {pk2(p[b0 + 0], p[b0 + 1]), pk2(p[b0 + 2], p[b0 + 3]), pk2(p[b0 + 4], p[b0 + 5]), pk2(p[b0 + 6], p[b0 + 7])};
    return __builtin_bit_cast(bf16x8, w);
}
typedef short v4i16_t __attribute__((ext_vector_type(4)));
__device__ __forceinline__ s16x4 vtr(LAS const unsigned char* p) { return __builtin_bit_cast(s16x4, __builtin_amdgcn_ds_read_tr16_b64_v4i16((LAS v4i16_t*)p)); }
#define MFMA32(a, b, c) __builtin_amdgcn_mfma_f32_32x32x16_bf16((a), (b), (c), 0, 0, 0)

#define XB_TMO      128
#define XB_XCNT(j)  (256  + 64 * (j))
#define XB_XSUB(j)  (1280 + 64 * (j))
#define XB_XGEN(j)  (2304 + 64 * (j))
#define XB_TOP      3328
#define XB_TOPGEN   3392
#define XCD_BAR_WORDS 3456
#define XB_SPIN_CAP (1u << 18)

__device__ __forceinline__ unsigned xb_ld(unsigned* p)              { return __hip_atomic_load(p, __ATOMIC_RELAXED, __HIP_MEMORY_SCOPE_AGENT); }
__device__ __forceinline__ unsigned xb_add(unsigned* p, unsigned v) { return __hip_atomic_fetch_add(p, v, __ATOMIC_RELAXED, __HIP_MEMORY_SCOPE_AGENT); }
__device__ __forceinline__ unsigned xb_xcc_id() { return (unsigned)__builtin_amdgcn_s_getreg((3 << 11) | 20) & 0xFu; }
#define XB_SPIN(cond, bar) do { unsigned _sp = 0; while (cond) { __builtin_amdgcn_s_sleep(1); \
    if ((++_sp & 255u) == 0u) { if (xb_ld(&(bar)[XB_TMO])) break; if (_sp > XB_SPIN_CAP) { atomicAdd(&(bar)[XB_TMO], 1u); break; } } } } while (0)

struct XcdBarrier {
    unsigned* bar; unsigned x;
    volatile LAS unsigned* st;
};

__device__ __forceinline__ XcdBarrier xcd_barrier_post(unsigned* bar, volatile LAS unsigned* st) {
    XcdBarrier b; b.bar = bar; b.x = xb_xcc_id(); b.st = st;
    if (threadIdx.x == 0) (void)xb_add(&bar[XB_XCNT(b.x)], 1u);
    return b;
}
__device__ __forceinline__ void xcd_barrier_complete(unsigned* bar, unsigned x, unsigned& nloc, unsigned& nx) {
    const unsigned G = gridDim.x * gridDim.y * gridDim.z;
    unsigned sum, cnt, mine, sp = 0u;
    for (;;) {
        sum = 0u; cnt = 0u; mine = 0u;
#pragma unroll
        for (unsigned j = 0; j < 16; ++j) { const unsigned c = xb_ld(&bar[XB_XCNT(j)]); sum += c; cnt += (c > 0u) ? 1u : 0u; mine = (j == x) ? c : mine; }
        if (sum == G) break;
        __builtin_amdgcn_s_sleep(1);
        if ((++sp & 255u) == 0u) { if (xb_ld(&bar[XB_TMO])) break; if (sp > XB_SPIN_CAP) { atomicAdd(&bar[XB_TMO], 1u); break; } }
    }
    nloc = mine > 0u ? mine : 1u; nx = cnt > 0u ? cnt : 1u;
}

__device__ __forceinline__ void xcd_barrier(const XcdBarrier& b) {
    asm volatile("s_waitcnt vmcnt(0)" ::: "memory");
    __syncthreads();
    if (threadIdx.x == 0) {
        unsigned* bar = b.bar;
        __builtin_amdgcn_s_waitcnt(0);
        unsigned nloc = b.st[0], nx = b.st[1];
        if (nloc == 0u) { xcd_barrier_complete(bar, b.x, nloc, nx); b.st[0] = nloc; b.st[1] = nx; }
        const unsigned old = xb_add(&bar[XB_XSUB(b.x)], 1u);
        const unsigned gen = old / nloc;
        if (old + 1u == (gen + 1u) * nloc) {
            __builtin_amdgcn_fence(__ATOMIC_RELEASE, "agent");
            asm volatile("s_waitcnt vmcnt(0)" ::: "memory");
            const unsigned og = xb_add(&bar[XB_TOP], 1u);
            const unsigned tg = og / nx;
            if (og + 1u == (tg + 1u) * nx) xb_add(&bar[XB_TOPGEN], 1u);
            else XB_SPIN(xb_ld(&bar[XB_TOPGEN]) == tg, bar);
            __builtin_amdgcn_fence(__ATOMIC_ACQUIRE, "agent");
            xb_add(&bar[XB_XGEN(b.x)], 1u);
            asm volatile("s_waitcnt vmcnt(0)" ::: "memory");
        } else {
            XB_SPIN(xb_ld(&bar[XB_XGEN(b.x)]) == gen, bar);
            __builtin_amdgcn_fence(__ATOMIC_ACQUIRE, "agent");
            asm volatile("s_waitcnt vmcnt(0)" ::: "memory");
        }
    }
    __syncthreads();
}


struct Args {
    const float* in[18]; float* out; unsigned char* ws; int ph_lo, ph_hi;
};

struct Ctx {
    LAS unsigned char* lds;
    unsigned char* ws;
    int tid, lane, wave, G, bid;
};

__device__ __forceinline__ void transpose_item(const float* W, int K, int Nsrc, int Ndst, bf16* WT, LAS float* scr, int item, int lane, int mode) {
    const int nblk = Ndst / 32, kb = item / nblk, nb = item % nblk, k0 = 64 * kb, n0 = 32 * nb;
    int s0 = n0; float sc = 1.f;
    if (mode == 1) { if (n0 >= GATE_SRC) s0 = n0 + 12; if (n0 < 512) sc = QA_SCALE; else if (n0 >= C_QB && n0 < C_QB + 512) sc = QB_SCALE; }
#pragma unroll 8
    for (int i = 0; i < 32; ++i) { const int kk = 2 * i + (lane >> 5); scr[kk * 33 + (lane & 31)] = W[(size_t)(k0 + kk) * Nsrc + s0 + (lane & 31)] * sc; }
    asm volatile("s_waitcnt lgkmcnt(0)" ::: "memory");
    const int c = lane & 7;
#pragma unroll
    for (int j = 0; j < 4; ++j) { const int n = (lane >> 3) + 8 * j; const LAS float* s = scr + (8 * c) * 33 + n;
        u32x4 o; o.x = pk2(s[0 * 33], s[1 * 33]); o.y = pk2(s[2 * 33], s[3 * 33]); o.z = pk2(s[4 * 33], s[5 * 33]); o.w = pk2(s[6 * 33], s[7 * 33]);
        *(u32x4*)(WT + (size_t)(n0 + n) * K + k0 + 8 * c) = o; }
    asm volatile("s_waitcnt lgkmcnt(0)" ::: "memory");
}

__device__ __forceinline__ void p0_prologue(const Ctx& X, const Args& a) {
    const float* c_in = a.in[1]; const float* w_ada = a.in[2]; const float* b_ada = a.in[3];
    const float* w_in = a.in[6]; const float* w_out = a.in[7]; const float* cmp_pos = a.in[13];
    const float* wk1 = a.in[14]; const float* wk2 = a.in[15]; const float* wv1 = a.in[16]; const float* wv2 = a.in[17];
    if (X.bid < 96) {
        LAS float* cond = (LAS float*)(X.lds);
        LAS float* red = (LAS float*)(X.lds + 65536);
        for (int e = X.tid; e < NB * DM; e += 512) { const int b = e >> 10, k = e & 1023; cond[k * 16 + b] = silu_f(c_in[e]); }
        __syncthreads();
        const int j0 = 32 * X.bid, cg4 = X.lane & 7, ks = X.lane >> 3;
        float acc[4][16];
#pragma unroll
        for (int c = 0; c < 4; ++c)
#pragma unroll
            for (int b = 0; b < 16; ++b) acc[c][b] = 0.f;
        for (int it = 0; it < 16; ++it) {
            const int k = 128 * X.wave + 8 * it + ks;
            const f32x4 wv = *(const f32x4*)(w_ada + (size_t)k * 3072 + j0 + 4 * cg4);
            const LAS f32x4* cp = (const LAS f32x4*)(cond + k * 16);
#pragma unroll
            for (int b4 = 0; b4 < 4; ++b4) { const f32x4 cv = cp[b4];
#pragma unroll
                for (int bb = 0; bb < 4; ++bb)
#pragma unroll
                    for (int c = 0; c < 4; ++c) acc[c][b4 * 4 + bb] += wv[c] * cv[bb]; }
        }
#pragma unroll
        for (int c = 0; c < 4; ++c)
#pragma unroll
            for (int b = 0; b < 16; ++b) { float v = acc[c][b]; v += __shfl_xor(v, 8); v += __shfl_xor(v, 16); v += __shfl_xor(v, 32); acc[c][b] = v; }
        if (ks == 0) {
#pragma unroll
            for (int c = 0; c < 4; ++c)
#pragma unroll
                for (int b = 0; b < 16; ++b) red[(X.wave * 32 + 4 * cg4 + c) * 16 + b] = acc[c][b];
        }
        __syncthreads();
        { const int col = X.tid >> 4, b = X.tid & 15; float s = 0.f;
#pragma unroll
          for (int w = 0; w < 8; ++w) s += red[(w * 32 + col) * 16 + b];
          float* mod = (float*)(X.ws + WS_MOD);
          mod[b * 3072 + j0 + col] = s + b_ada[j0 + col]; }
        __syncthreads();
    }
    LAS float* scr = (LAS float*)(X.lds + X.wave * 16384);
    const int gw = X.bid * 8 + X.wave, NGW = X.G * 8;
    constexpr int I_IN = 16 * 120, I_OUT = 16 * 32, I_C1 = 64 * 4, I_C2 = 2 * 4, I_B1 = 128;
    constexpr int NITEMS = I_IN + I_OUT + 2 * I_C1 + 2 * I_C2 + I_B1;
    for (int it = gw; it < NITEMS; it += NGW) {
        int r = it;
        if (r < I_IN) { transpose_item(w_in, 1024, DIN_SRC, UP, (bf16*)(X.ws + WS_WIN), scr, r, X.lane, 1); continue; } r -= I_IN;
        if (r < I_OUT) { transpose_item(w_out, 1024, 1024, 1024, (bf16*)(X.ws + WS_WOUT), scr, r, X.lane, 0); continue; } r -= I_OUT;
        if (r < I_C1) { transpose_item(wk1, 4096, 128, 128, (bf16*)(X.ws + WS_WK1), scr, r, X.lane, 0); continue; } r -= I_C1;
        if (r < I_C1) { transpose_item(wv1, 4096, 128, 128, (bf16*)(X.ws + WS_WV1), scr, r, X.lane, 0); continue; } r -= I_C1;
        if (r < I_C2) { transpose_item(wk2, 128, 128, 128, (bf16*)(X.ws + WS_WK2), scr, r, X.lane, 0); continue; } r -= I_C2;
        if (r < I_C2) { transpose_item(wv2, 128, 128, 128, (bf16*)(X.ws + WS_WV2), scr, r, X.lane, 0); continue; } r -= I_C2;
        {
            const int kv = r >> 6, p = r & 63; const float* w1 = kv ? wv1 : wk1;
            float a0 = 0.f, a1 = 0.f;
#pragma unroll 8
            for (int kk = 0; kk < 64; ++kk) { const int k = 64 * p + kk; const float pv = cmp_pos[k]; a0 += pv * w1[(size_t)k * 128 + X.lane]; a1 += pv * w1[(size_t)k * 128 + 64 + X.lane]; }
            float* bp = (float*)(X.ws + WS_B1P) + (kv * 64 + p) * 128; bp[X.lane] = a0; bp[64 + X.lane] = a1;
        }
    }
}

__device__ __forceinline__ void p1_norm(const Ctx& X, const Args& a) {
    const float* x = a.in[0]; const float* g_pre = a.in[4]; const float* w_in = a.in[6];
    const float* mod = (const float*)(X.ws + WS_MOD);
    bf16* H = (bf16*)(X.ws + WS_H); float* G = (float*)(X.ws + WS_GATES);
    LAS float* Wg = (LAS float*)X.lds;
    for (int k = X.tid; k < 1024; k += 512) {
        const f32x4* src = (const f32x4*)(w_in + (size_t)k * DIN_SRC + GATE_SRC);
        LAS f32x4* dst = (LAS f32x4*)(Wg + k * 12); dst[0] = src[0]; dst[1] = src[1]; dst[2] = src[2];
    }
    __syncthreads();
    const int gw = X.bid * 8 + X.wave, NGW = X.G * 8;
    for (int grp = gw; grp < M / 16; grp += NGW) {
        const int row0 = grp * 16, b = row0 / T;
        f32x4 gs[4], sh[4];
#pragma unroll
        for (int j = 0; j < 4; ++j) { const int k = 256 * j + 4 * X.lane;
            const f32x4 g = *(const f32x4*)(g_pre + k), sc = *(const f32x4*)(mod + b * 3072 + 1024 + k); sh[j] = *(const f32x4*)(mod + b * 3072 + k);
            gs[j] = g * (1.f + sc); }
        constexpr int RP = 2;
        for (int ps = 0; ps < 16 / RP; ++ps) {
            asm volatile("" ::: "memory");
            f32x4 xv[RP][4]; float rs[RP];
#pragma unroll
            for (int r = 0; r < RP; ++r) { const float* xr = x + (size_t)(row0 + RP * ps + r) * DM + 4 * X.lane; float s = 0.f;
#pragma unroll
                for (int j = 0; j < 4; ++j) { xv[r][j] = *(const f32x4*)(xr + 256 * j); const f32x4 v = xv[r][j]; s += (v.x * v.x + v.y * v.y) + (v.z * v.z + v.w * v.w); }
                rs[r] = s; }
#pragma unroll
            for (int r = 0; r < RP; ++r) rs[r] = rsqrtf(wave_sum(rs[r]) * (1.f / DM) + NORM_EPS);
            float ga[RP][12];
#pragma unroll
            for (int r = 0; r < RP; ++r)
#pragma unroll
                for (int g = 0; g < 12; ++g) ga[r][g] = 0.f;
#pragma unroll
            for (int j = 0; j < 4; ++j) {
#pragma unroll
                for (int r = 0; r < RP; ++r) { xv[r][j] = xv[r][j] * rs[r] * gs[j] + sh[j];
                    u32x2 o; o.x = pk2(xv[r][j].x, xv[r][j].y); o.y = pk2(xv[r][j].z, xv[r][j].w);
                    *(u32x2*)(H + (size_t)(row0 + RP * ps + r) * DM + 256 * j + 4 * X.lane) = o; }
#pragma unroll
                for (int e = 0; e < 4; ++e) { const LAS f32x4* wp = (const LAS f32x4*)(Wg + (256 * j + 4 * X.lane + e) * 12);
                    const f32x4 w0 = wp[0], w1 = wp[1], w2 = wp[2];
#pragma unroll
                    for (int r = 0; r < RP; ++r) { const float hv = xv[r][j][e];
                        ga[r][0] += hv * w0.x; ga[r][1] += hv * w0.y; ga[r][2] += hv * w0.z; ga[r][3] += hv * w0.w;
                        ga[r][4] += hv * w1.x; ga[r][5] += hv * w1.y; ga[r][6] += hv * w1.z; ga[r][7] += hv * w1.w;
                        ga[r][8] += hv * w2.x; ga[r][9] += hv * w2.y; ga[r][10] += hv * w2.z; ga[r][11] += hv * w2.w; } }
            }
#pragma unroll
            for (int r = 0; r < RP; ++r)
#pragma unroll
                for (int g = 0; g < 12; ++g) ga[r][g] = wave_sum(ga[r][g]);
            if (X.lane < RP * 12) { const int r = X.lane / 12, g = X.lane % 12; float v = 0.f;
#pragma unroll
                for (int rr = 0; rr < RP; ++rr)
#pragma unroll
                    for (int gg = 0; gg < 12; ++gg) if (rr == r && gg == g) v = ga[rr][gg];
                G[(size_t)(row0 + RP * ps + r) * 16 + g] = sigmoid_f(v); }
        }
    }
}

__device__ __forceinline__ void p6_final(const Ctx& X, const Args& a) {
    const float* x = a.in[0]; const float* g_post = a.in[5]; float* out = a.out;
    const float* mod = (const float*)(X.ws + WS_MOD); const bf16* Y = (const bf16*)(X.ws + WS_Y);
    const int gw = X.bid * 8 + X.wave, NGW = X.G * 8;
    for (int grp = gw; grp < M / 16; grp += NGW) {
        const int row0 = grp * 16, b = row0 / T;
        f32x4 gp[2][2];
#pragma unroll
        for (int j = 0; j < 2; ++j)
#pragma unroll
            for (int e = 0; e < 2; ++e) { const int k = 512 * j + 8 * X.lane + 4 * e; gp[j][e] = *(const f32x4*)(g_post + k) * *(const f32x4*)(mod + b * 3072 + 2048 + k); }
        for (int r = 0; r < 16; ++r) {
            const size_t ro = (size_t)(row0 + r) * DM;
            u32x4 yv[2]; f32x4 xv[2][2]; float s = 0.f;
#pragma unroll
            for (int j = 0; j < 2; ++j) { yv[j] = *(const u32x4*)(Y + ro + 512 * j + 8 * X.lane); xv[j][0] = *(const f32x4*)(x + ro + 512 * j + 8 * X.lane); xv[j][1] = *(const f32x4*)(x + ro + 512 * j + 8 * X.lane + 4); }
            f32x4 yf[2][2];
#pragma unroll
            for (int j = 0; j < 2; ++j) { yf[j][0] = (f32x4){bflo(yv[j].x), bfhi(yv[j].x), bflo(yv[j].y), bfhi(yv[j].y)}; yf[j][1] = (f32x4){bflo(yv[j].z), bfhi(yv[j].z), bflo(yv[j].w), bfhi(yv[j].w)};
#pragma unroll
                for (int e = 0; e < 2; ++e) { const f32x4 v = yf[j][e]; s += (v.x * v.x + v.y * v.y) + (v.z * v.z + v.w * v.w); } }
            const float rstd = rsqrtf(wave_sum(s) * (1.f / DM) + NORM_EPS);
#pragma unroll
            for (int j = 0; j < 2; ++j)
#pragma unroll
                for (int e = 0; e < 2; ++e) *(f32x4*)(out + ro + 512 * j + 8 * X.lane + 4 * e) = xv[j][e] + yf[j][e] * rstd * gp[j][e];
        }
    }
}

__device__ __forceinline__ void stage_load(u32x4 (&r)[4], const bf16* Kg, const bf16* Vg, int pitch, int tid) {
#pragma unroll
    for (int i = 0; i < 2; ++i) { const int c = tid + 512 * i, key = c >> 4, col = c & 15;
        r[i] = *(const u32x4*)(Kg + (size_t)key * pitch + col * 8); r[2 + i] = *(const u32x4*)(Vg + (size_t)key * pitch + col * 8); }
}
__device__ __forceinline__ void stage_store(LAS unsigned char* buf, const u32x4 (&r)[4], int tid) {
#pragma unroll
    for (int i = 0; i < 2; ++i) { const int c = tid + 512 * i, key = c >> 4, col = c & 15;
        *(LAS u32x4*)(buf + key * KSTR + col * 16) = r[i]; *(LAS u32x4*)(buf + KT_BYTES + key * VSTR + col * 16) = r[2 + i]; }
}
template <int KS>
__device__ __forceinline__ void qk_tile(f32x16& p0, f32x16& p1, LAS const unsigned char* kb, const bf16x8 (&qf)[KS]) {
#pragma unroll
    for (int r = 0; r < 16; ++r) { p0[r] = 0.f; p1[r] = 0.f; }
#pragma unroll
    for (int s = 0; s < KS; ++s) {
        const bf16x8 a0 = *(LAS const bf16x8*)(kb + s * 32), a1 = *(LAS const bf16x8*)(kb + 32 * KSTR + s * 32);
        p0 = MFMA32(a0, qf[s], p0); p1 = MFMA32(a1, qf[s], p1);
        if (s & 1) __builtin_amdgcn_sched_barrier(0);
    }
}
__device__ __forceinline__ void pv_tile(f32x16 (&o)[4], LAS const unsigned char* vb, bf16x8 pb0, bf16x8 pb1, bf16x8 pb2, bf16x8 pb3) {
#pragma unroll
    for (int db = 0; db < 4; ++db) {
        s16x4 lo[4], hi[4];
#pragma unroll
        for (int ks = 0; ks < 4; ++ks) { lo[ks] = vtr(vb + (16 * ks) * VSTR + db * 64); hi[ks] = vtr(vb + (16 * ks + 8) * VSTR + db * 64); }
#define PKV(k) (bf16x8){lo[k][0], lo[k][1], lo[k][2], lo[k][3], hi[k][0], hi[k][1], hi[k][2], hi[k][3]}
        o[db] = MFMA32(PKV(0), pb0, o[db]); o[db] = MFMA32(PKV(1), pb1, o[db]); o[db] = MFMA32(PKV(2), pb2, o[db]); o[db] = MFMA32(PKV(3), pb3, o[db]);
#undef PKV
        __builtin_amdgcn_sched_barrier(0);
    }
}

template <int KS>
__device__ __forceinline__ void attend(const Ctx& X, f32x16 (&o)[4], float& m, float& l, const bf16x8 (&qf)[KS], const bf16* Kg, const bf16* Vg, int kcolB,
                                       unsigned tilemask, int qp, int qw0, int W, unsigned selbits, float s2, int refpos) {
    const int lane = X.lane, hi = lane >> 5, q5 = lane & 31;
    const int koff = q5 * KSTR + hi * 16 + kcolB;
    const int voff = KT_BYTES + (4 * hi + ((lane & 15) >> 2)) * VSTR + (16 * ((lane >> 4) & 1) + 4 * (lane & 3)) * 2;
    const float NEGINF = -__builtin_inff();
    unsigned tm = tilemask;
    int jt = __ffs(tm) - 1; tm &= tm - 1;
    u32x4 sr[4];
    stage_load(sr, Kg + (size_t)(64 * jt) * UP, Vg + (size_t)(64 * jt) * UP, UP, X.tid);
    stage_store(X.lds + L_BUF0, sr, X.tid);
    __syncthreads();
    int cur = 0;
    for (;;) {
        const int jn = tm ? (__ffs(tm) - 1) : -1;
        if (jn >= 0) { tm &= tm - 1; stage_load(sr, Kg + (size_t)(64 * jn) * UP, Vg + (size_t)(64 * jn) * UP, UP, X.tid); }
        LAS const unsigned char* buf = X.lds + (cur ? L_BUF1 : L_BUF0);
        const bool lanebit = (selbits >> jt) & 1u;
        const bool skip = (64 * jt > qw0 + 31) || (qw0 - 64 * jt - 63 >= W) || !__any(lanebit);
        if (!skip) {
            f32x16 p0, p1;
            qk_tile<KS>(p0, p1, buf + koff, qf);
            const float bb = s2 * (float)(64 * jt + 4 * hi - refpos);
#pragma unroll
            for (int r = 0; r < 16; ++r) { const int c = (r & 3) + 8 * (r >> 2); p0[r] += fmaf(s2, (float)c, bb); p1[r] += fmaf(s2, (float)(c + 32), bb); }
            const bool needmask = !__all(lanebit) || (64 * jt + 63 > qw0) || (qw0 + 31 - 64 * jt >= W);
            if (needmask) {
                const int dq = qp - 64 * jt - 4 * hi;
#pragma unroll
                for (int r = 0; r < 16; ++r) { const int c = (r & 3) + 8 * (r >> 2);
                    if (!(lanebit && (unsigned)(dq - c) < (unsigned)W)) p0[r] = NEGINF;
                    if (!(lanebit && (unsigned)(dq - c - 32) < (unsigned)W)) p1[r] = NEGINF; }
            }
            float mx = fmaxf(p0[0], p1[0]);
#pragma unroll
            for (int r = 1; r < 16; ++r) mx = fmaxf(mx, fmaxf(p0[r], p1[r]));
            mx = xhalf_max(mx);
            if (!__all(mx - m <= 8.f)) {
                const float mn = fmaxf(m, mx), alpha = __builtin_amdgcn_exp2f(m - mn); m = mn; l *= alpha;
#pragma unroll
                for (int db = 0; db < 4; ++db) o[db] = o[db] * alpha;
            }
            float ps = 0.f;
#pragma unroll
            for (int r = 0; r < 16; ++r) { p0[r] = __builtin_amdgcn_exp2f(p0[r] - m); p1[r] = __builtin_amdgcn_exp2f(p1[r] - m); ps += p0[r] + p1[r]; }
            l += xhalf_sum(ps);
            pv_tile(o, buf + voff, pack8(p0, 0), pack8(p0, 8), pack8(p1, 0), pack8(p1, 8));
        }
        if (jn >= 0) stage_store(X.lds + (cur ? L_BUF0 : L_BUF1), sr, X.tid);
        __syncthreads();
        if (jn < 0) break;
        jt = jn; cur ^= 1;
    }
}

__device__ __forceinline__ void diff_unit(const Ctx& X, const Args& a, int b, int h, int qb) {
    const bf16* U = (const bf16*)(X.ws + WS_U); bf16* CAT = (bf16*)(X.ws + WS_CAT);
    const int w = X.wave, lane = X.lane, c = w >> 2, tq = w & 3, hi = lane >> 5, q5 = lane & 31;
    const int qw0 = 128 * qb + 32 * tq, qp = qw0 + q5;
    const size_t row = (size_t)b * T + qp;
    bf16x8 qf[4];
#pragma unroll
    for (int s = 0; s < 4; ++s) qf[s] = *(const bf16x8*)(U + row * UP + C_QA + 128 * h + 64 * c + 16 * s + 8 * hi);
    const float s2 = exp2f(-2.f * (float)(h + 1)) * LOG2E;
    f32x16 o[4];
#pragma unroll
    for (int db = 0; db < 4; ++db)
#pragma unroll
        for (int r = 0; r < 16; ++r) o[db][r] = 0.f;
    float m = -1e30f, l = 0.f;
    const int nt = 2 * qb + 2;
    const unsigned tilemask = nt >= 32 ? 0xffffffffu : ((1u << nt) - 1u);
    const bf16* Ub = U + (size_t)b * T * UP;
    attend<4>(X, o, m, l, qf, Ub + C_KA + 128 * h, Ub + C_VA + 128 * h, 128 * c, tilemask, qp, qw0, 0x7fffffff, 0xffffffffu, s2, 128 * qb);
    const float inv = 1.f / l;
    LAS float* xch = (LAS float*)(X.lds + L_XCH) + tq * 4096;
    if (c == 1) {
#pragma unroll
        for (int db = 0; db < 4; ++db)
#pragma unroll
            for (int r = 0; r < 16; ++r) xch[(db * 16 + r) * 64 + lane] = o[db][r] * inv;
    }
    __syncthreads();
    if (c == 0) {
        const float d1 = wave_sum(a.in[8][lane] * a.in[9][lane]), d2 = wave_sum(a.in[10][lane] * a.in[11][lane]);
        const float lam = __expf(d1) - __expf(d2) + LAM_INIT;
        float ss = 0.f;
#pragma unroll
        for (int db = 0; db < 4; ++db)
#pragma unroll
            for (int r = 0; r < 16; ++r) { const float v = o[db][r] * inv - lam * xch[(db * 16 + r) * 64 + lane]; o[db][r] = v; ss += v * v; }
        ss = xhalf_sum(ss);
        const float rstd = rsqrtf(ss * (1.f / 128.f) + NORM_EPS) * (1.f - LAM_INIT);
        const float* gsub = a.in[12];
#pragma unroll
        for (int db = 0; db < 4; ++db)
#pragma unroll
            for (int g4 = 0; g4 < 4; ++g4) {
                const int d0 = 32 * db + 8 * g4 + 4 * hi;
                const u32x2 zz = *(const u32x2*)(U + row * UP + C_ZA + 128 * h + d0);
                const f32x4 gv = *(const f32x4*)(gsub + d0);
                const float v0 = o[db][4 * g4 + 0] * rstd * gv.x * silu_f(bflo(zz.x)), v1 = o[db][4 * g4 + 1] * rstd * gv.y * silu_f(bfhi(zz.x));
                const float v2 = o[db][4 * g4 + 2] * rstd * gv.z * silu_f(bflo(zz.y)), v3 = o[db][4 * g4 + 3] * rstd * gv.w * silu_f(bfhi(zz.y));
                u32x2 ov; ov.x = pk2(v0, v1); ov.y = pk2(v2, v3);
                *(u32x2*)(CAT + row * DM + 128 * h + d0) = ov;
            }
    }
    __syncthreads();
}

__device__ __forceinline__ void compress_unit(const Ctx& X, const Args& a, int item) {
    const int kv = item & 1, rg = (item >> 1) & 3, b = item >> 3;
    const bf16* U = (const bf16*)(X.ws + WS_U);
    const bf16* W1t = (const bf16*)(X.ws + (kv ? WS_WV1 : WS_WK1)); const bf16* W2t = (const bf16*)(X.ws + (kv ? WS_WV2 : WS_WK2));
    bf16* outp = (bf16*)(X.ws + (kv ? WS_VCMP : WS_KCMP)) + (size_t)b * 128 * 128;
    const float* B1P = (const float*)(X.ws + WS_B1P);
    const int colbase = kv ? C_VC : C_KC;
    const int w = X.wave, lane = X.lane, hi = lane >> 5, q5 = lane & 31;
    const int cidx = 32 * rg + q5, cc = cidx < NCMP ? cidx : NCMP - 1;
    f32x16 g[4];
#pragma unroll
    for (int nb = 0; nb < 4; ++nb)
#pragma unroll
        for (int r = 0; r < 16; ++r) g[nb][r] = 0.f;
    for (int lt = 4 * w; lt < 4 * w + 4; ++lt) {
        const bf16* arow = U + ((size_t)b * T + 16 * cc + lt) * UP + colbase + 8 * hi;
        const bf16* wrow = W1t + (size_t)q5 * 4096 + lt * 128 + 8 * hi;
#pragma unroll 2
        for (int s = 0; s < 8; ++s) {
            const bf16x8 bfr = *(const bf16x8*)(arow + 16 * s);
#pragma unroll
            for (int nb = 0; nb < 4; ++nb) { const bf16x8 afr = *(const bf16x8*)(wrow + (size_t)nb * 32 * 4096 + 16 * s); g[nb] = MFMA32(afr, bfr, g[nb]); }
        }
    }
    LAS float* red = (LAS float*)X.lds;
    LAS float* bias = (LAS float*)(X.lds + 131072);
    LAS bf16* gact = (LAS bf16*)(X.lds + 131072 + 1024);
#pragma unroll
    for (int nb = 0; nb < 4; ++nb)
#pragma unroll
        for (int r = 0; r < 16; ++r) red[(w * 64 + nb * 16 + r) * 64 + lane] = g[nb][r];
    if (X.tid < 128) { float s = 0.f; for (int p = 0; p < 64; ++p) s += B1P[(kv * 64 + p) * 128 + X.tid]; bias[X.tid] = s; }
    __syncthreads();
#pragma unroll
    for (int ii = 0; ii < 8; ++ii) {
        const int idx = 8 * w + ii; float s = 0.f;
#pragma unroll
        for (int ww = 0; ww < 8; ++ww) s += red[(ww * 64 + idx) * 64 + lane];
        const int n = 32 * (idx >> 4) + crow(idx & 15, hi);
        const float v = gelu_tanh(s + bias[n]);
        gact[q5 * 136 + n] = (bf16)(pk2(v, 0.f) & 0xffffu);
    }
    __syncthreads();
    if (w < 4) {
        f32x16 acc;
#pragma unroll
        for (int r = 0; r < 16; ++r) acc[r] = 0.f;
#pragma unroll
        for (int s = 0; s < 8; ++s) {
            const bf16x8 bfr = *(LAS const bf16x8*)(gact + q5 * 136 + 16 * s + 8 * hi);
            const bf16x8 afr = *(const bf16x8*)(W2t + (size_t)(32 * w + q5) * 128 + 16 * s + 8 * hi);
            acc = MFMA32(afr, bfr, acc);
        }
#pragma unroll
        for (int g4 = 0; g4 < 4; ++g4) {
            const int n2 = 32 * w + 8 * g4 + 4 * hi;
            u32x2 ov; ov.x = pk2(acc[4 * g4 + 0], acc[4 * g4 + 1]); ov.y = pk2(acc[4 * g4 + 2], acc[4 * g4 + 3]);
            if (cidx >= NCMP) { ov.x = 0u; ov.y = 0u; }
            *(u32x2*)(outp + (size_t)cidx * 128 + n2) = ov;
        }
    }
    __syncthreads();
}

__device__ __forceinline__ void nsa_unit(const Ctx& X, const Args& a, int b, int i) {
    const bf16* U = (const bf16*)(X.ws + WS_U); bf16* CAT = (bf16*)(X.ws + WS_CAT); const float* G = (const float*)(X.ws + WS_GATES);
    const int w = X.wave, lane = X.lane, hi = lane >> 5, q5 = lane & 31, h = w >> 1, th = w & 1;
    const int qw0 = 64 * i + 32 * th, qp = qw0 + q5;
    const size_t row = (size_t)b * T + qp;
    bf16x8 qf[8];
#pragma unroll
    for (int s = 0; s < 8; ++s) qf[s] = *(const bf16x8*)(U + row * UP + C_QB + 128 * h + 16 * s + 8 * hi);
    const float s2 = exp2f(-2.f * (float)(h + 1)) * LOG2E;
    const float g0 = G[row * 16 + h], g1 = G[row * 16 + 4 + h], g2 = G[row * 16 + 8 + h];
    f32x4* accp = (f32x4*)((float*)(X.ws + WS_NSAACC) + (((size_t)X.bid * 8 + w) * 64 + lane) * 64);
    const bf16* Ub = U + (size_t)b * T * UP;
    LAS float* imp = (LAS float*)(X.lds + L_XCH);
    LAS unsigned* selm = (LAS unsigned*)(X.lds + L_MISC + 256);
    const float NEGINF = -__builtin_inff();
    const int koff = q5 * KSTR + hi * 16;
    const int voff = KT_BYTES + (4 * hi + ((lane & 15) >> 2)) * VSTR + (16 * ((lane >> 4) & 1) + 4 * (lane & 3)) * 2;
#ifndef NSA_PARTS
#define NSA_PARTS 7
#endif
    if (NSA_PARTS & 1) {
    f32x16 A[4];
#pragma unroll
    for (int db = 0; db < 4; ++db)
#pragma unroll
        for (int r = 0; r < 16; ++r) A[db][r] = 0.f;
    {
        const int nct = (4 * i + 3 + 63) >> 6;
        const bf16* Kc = (const bf16*)(X.ws + WS_KCMP) + (size_t)b * 128 * 128; const bf16* Vc = (const bf16*)(X.ws + WS_VCMP) + (size_t)b * 128 * 128;
        u32x4 sr[4];
        stage_load(sr, Kc, Vc, 128, X.tid); stage_store(X.lds + L_BUF0, sr, X.tid);
        if (nct > 1) { stage_load(sr, Kc + 64 * 128, Vc + 64 * 128, 128, X.tid); stage_store(X.lds + L_BUF1, sr, X.tid); }
        __syncthreads();
        f32x16 p[4];
        qk_tile<8>(p[0], p[1], X.lds + L_BUF0 + koff, qf);
        if (nct > 1) qk_tile<8>(p[2], p[3], X.lds + L_BUF1 + koff, qf);
        else {
#pragma unroll
            for (int r = 0; r < 16; ++r) { p[2][r] = 0.f; p[3][r] = 0.f; }
        }
        float mx = NEGINF;
        int lim = qp - 64 * hi - 31; float bb0 = s2 * (float)(64 * hi + 31 - 64 * i);
        asm volatile("" : "+v"(lim), "+v"(bb0));
#pragma unroll
        for (int hh = 0; hh < 4; ++hh)
#pragma unroll
            for (int r = 0; r < 16; ++r) { const int CC = 16 * (32 * hh + (r & 3) + 8 * (r >> 2));
                const bool ok = (CC <= lim) && (hh < 2 * nct);
                const float t = ok ? p[hh][r] + fmaf(s2, (float)CC, bb0) : NEGINF; p[hh][r] = t; mx = fmaxf(mx, t); }
        mx = xhalf_max(mx);
        const float mm = (mx == NEGINF) ? 0.f : mx;
        float sum = 0.f;
#pragma unroll
        for (int hh = 0; hh < 4; ++hh)
#pragma unroll
            for (int r = 0; r < 16; ++r) { const float e = __builtin_amdgcn_exp2f(p[hh][r] - mm); p[hh][r] = e; sum += e; }
        sum = xhalf_sum(sum);
        const float inv = sum > 0.f ? 1.f / sum : 0.f;
        float av[16], bv[16];
#pragma unroll
        for (int hh = 0; hh < 4; ++hh)
#pragma unroll
            for (int g4 = 0; g4 < 4; ++g4) { const float t3 = 0.5f * p[hh][4 * g4 + 3] * inv;
                av[hh * 4 + g4] = (p[hh][4 * g4] + p[hh][4 * g4 + 1] + p[hh][4 * g4 + 2]) * inv + t3; bv[hh * 4 + g4] = t3; }
#pragma unroll
        for (int idx = 0; idx < 16; ++idx) bv[idx] = __shfl_xor(bv[idx], 32);
#pragma unroll
        for (int idx = 0; idx < 16; ++idx) { const float add = hi ? bv[idx] : (idx > 0 ? bv[idx > 0 ? idx - 1 : 0] : 0.f);
            imp[(h * 64 + 32 * th + q5) * 33 + 2 * idx + hi] = av[idx] + add; }
        const float sc = inv * g0;
#pragma unroll
        for (int hh = 0; hh < 4; ++hh) p[hh] = p[hh] * sc;
        pv_tile(A, X.lds + L_BUF0 + voff, pack8(p[0], 0), pack8(p[0], 8), pack8(p[1], 0), pack8(p[1], 8));
        if (nct > 1) pv_tile(A, X.lds + L_BUF1 + voff, pack8(p[2], 0), pack8(p[2], 8), pack8(p[3], 0), pack8(p[3], 8));
        __syncthreads();
        if (w == 0) {
            unsigned mask;
            if (i + 1 <= 8) mask = (1u << (i + 1)) - 1u;
            else {
                LAS float* s0 = imp + lane * 33;
                for (int j = 1; j < i; ++j) s0[j] = ((s0[j] + imp[(64 + lane) * 33 + j]) + imp[(128 + lane) * 33 + j]) + imp[(192 + lane) * 33 + j];
                mask = 1u | (1u << i);
                for (int k = 0; k < 6; ++k) { float best = NEGINF; int bj = 1;
                    for (int j = 1; j < i; ++j) { const float s = s0[j]; if (!((mask >> j) & 1u) && s > best) { best = s; bj = j; } }
                    mask |= 1u << bj; }
            }
            selm[lane] = mask;
            unsigned um = mask;
#pragma unroll
            for (int o = 1; o < 64; o <<= 1) um |= __shfl_xor(um, o);
            if (lane == 0) selm[64] = um;
        }
        __syncthreads();
    }
#pragma unroll
    for (int db = 0; db < 4; ++db)
#pragma unroll
        for (int g4 = 0; g4 < 4; ++g4) accp[db * 4 + g4] = (f32x4){A[db][4 * g4], A[db][4 * g4 + 1], A[db][4 * g4 + 2], A[db][4 * g4 + 3]};
    }
    f32x16 o[4]; float m, l;
    if (NSA_PARTS & 2) {
        const unsigned uni = selm[64], mybits = selm[32 * th + q5];
#pragma unroll
        for (int db = 0; db < 4; ++db)
#pragma unroll
            for (int r = 0; r < 16; ++r) o[db][r] = 0.f;
        m = -1e30f; l = 0.f;
        attend<8>(X, o, m, l, qf, Ub + C_KS, Ub + C_VS, 0, uni, qp, qw0, 0x7fffffff, mybits, s2, 64 * i);
        const float sc = g1 / l;
#pragma unroll
        for (int db = 0; db < 4; ++db)
#pragma unroll
            for (int g4 = 0; g4 < 4; ++g4) { f32x4 v = accp[db * 4 + g4];
                v.x += o[db][4 * g4] * sc; v.y += o[db][4 * g4 + 1] * sc; v.z += o[db][4 * g4 + 2] * sc; v.w += o[db][4 * g4 + 3] * sc; accp[db * 4 + g4] = v; }
    }
    if (NSA_PARTS & 4) {
        const int j0 = i >= 4 ? i - 4 : 0;
        const unsigned wmask = (i >= 31 ? 0xffffffffu : ((1u << (i + 1)) - 1u)) & ~((1u << j0) - 1u);
#pragma unroll
        for (int db = 0; db < 4; ++db)
#pragma unroll
            for (int r = 0; r < 16; ++r) o[db][r] = 0.f;
        m = -1e30f; l = 0.f;
        attend<8>(X, o, m, l, qf, Ub + C_KW, Ub + C_VW, 0, wmask, qp, qw0, 256, 0xffffffffu, s2, 64 * i);
        const float sc = g2 / l;
#pragma unroll
        for (int db = 0; db < 4; ++db)
#pragma unroll
            for (int g4 = 0; g4 < 4; ++g4) { const f32x4 v = accp[db * 4 + g4];
                o[db][4 * g4] = v.x + o[db][4 * g4] * sc; o[db][4 * g4 + 1] = v.y + o[db][4 * g4 + 1] * sc; o[db][4 * g4 + 2] = v.z + o[db][4 * g4 + 2] * sc; o[db][4 * g4 + 3] = v.w + o[db][4 * g4 + 3] * sc; }
    }
#pragma unroll
    for (int db = 0; db < 4; ++db)
#pragma unroll
        for (int g4 = 0; g4 < 4; ++g4) {
            const int d0 = 32 * db + 8 * g4 + 4 * hi;
            const u32x2 zz = *(const u32x2*)(U + row * UP + C_ZB + 128 * h + d0);
            const float v0 = o[db][4 * g4 + 0] * silu_f(bflo(zz.x)), v1 = o[db][4 * g4 + 1] * silu_f(bfhi(zz.x));
            const float v2 = o[db][4 * g4 + 2] * silu_f(bflo(zz.y)), v3 = o[db][4 * g4 + 3] * silu_f(bfhi(zz.y));
            u32x2 ov; ov.x = pk2(v0, v1); ov.y = pk2(v2, v3);
            *(u32x2*)(CAT + row * DM + 512 + 128 * h + d0) = ov;
        }
}

__device__ __forceinline__ int q_next(const Ctx& X, unsigned* ctr) {
    LAS int* slot = (LAS int*)(X.lds + L_MISC);
    __syncthreads();
    if (X.tid == 0) *slot = (int)atomicAdd(ctr, 1u) + X.G;
    __syncthreads();
    return *slot;
}

__global__ void __launch_bounds__(512, 2) fwd_kernel(Args a) {
    extern __shared__ __attribute__((aligned(16))) unsigned char lds_raw[];
    Ctx X;
    X.lds = (LAS unsigned char*)lds_raw; X.ws = a.ws;
    X.tid = threadIdx.x; X.lane = X.tid & 63; X.wave = __builtin_amdgcn_readfirstlane(X.tid >> 6); X.G = gridDim.x; X.bid = blockIdx.x;
    cg::grid_group grid = cg::this_grid();
    const int lo = a.ph_lo, hi = a.ph_hi;
    volatile LAS unsigned* xst = (volatile LAS unsigned*)(X.lds + L_MISC + 1024);
    if (X.tid < 4) xst[X.tid] = 0u;
    __syncthreads();
    XcdBarrier bar = xcd_barrier_post((unsigned*)(X.ws + WS_CTL) + CW_BAR, xst);
#ifndef PH_MASK
#define PH_MASK 0x7f
#endif
#define IN(k) (((PH_MASK >> (k)) & 1) && lo <= (k) && (k) < hi)
#define SEAM(k) do { if (IN(k) && IN((k) + 1)) { if ((k) == CG_SEAM) grid.sync(); else xcd_barrier(bar); } } while (0)
#ifndef CG_SEAM
#define CG_SEAM 0
#endif
    if (IN(0)) p0_prologue(X, a);
    SEAM(0);
    if (IN(1)) p1_norm(X, a);
    SEAM(1);
    if (IN(2)) {
        pg8::Gemm g{(const pg8::bf16_t*)(X.ws + WS_H), (const pg8::bf16_t*)(X.ws + WS_WIN), M, UP, 1024};
        pg8::StaticOrder S; S.init(M, UP, X.G, X.bid);
        pg8::EpiBf16<0> E{(pg8::bf16_t*)(X.ws + WS_U), UP, nullptr, 0, 0, 1.f};
        pg8::gemm_phase<pg8::EpiBf16<0>, pg8::StaticOrder, true, true>(X.lds, g, S, E);
    }
    SEAM(2);
    if (IN(3)) {
        unsigned* ctr = (unsigned*)(X.ws + WS_CTL) + CW_Q3;
        constexpr int NITEMS = 128 + 1024;
        int it = X.bid;
        for (; it < 128; it = q_next(X, ctr)) compress_unit(X, a, it);
        for (; it < NITEMS; it = q_next(X, ctr)) { const int u = it - 128, qb = 15 - (u >> 6), bh = u & 63; diff_unit(X, a, bh >> 2, bh & 3, qb); }
    }
    SEAM(3);
    if (IN(4)) {
        unsigned* ctr = (unsigned*)(X.ws + WS_CTL) + CW_Q4;
        for (int it = X.bid; it < 512; it = q_next(X, ctr)) { const int i = 31 - (it >> 4), b = it & 15; nsa_unit(X, a, b, i); }
    }
    SEAM(4);
    if (IN(5)) {
        pg8::Gemm g{(const pg8::bf16_t*)(X.ws + WS_CAT), (const pg8::bf16_t*)(X.ws + WS_WOUT), M, DM, 1024};
        pg8::StaticOrder S; S.init(M, DM, X.G, X.bid);
        pg8::EpiBf16<0> E{(pg8::bf16_t*)(X.ws + WS_Y), DM, nullptr, 0, 0, 1.f};
        pg8::gemm_phase<pg8::EpiBf16<0>, pg8::StaticOrder, true, true>(X.lds, g, S, E);
    }
    SEAM(5);
    if (IN(6)) p6_final(X, a);
#undef IN
#undef SEAM
}

#ifndef N_LAUNCHES
#define N_LAUNCHES 1
#endif
extern "C" void kernel_launch(void* const* d_in, const int* in_sizes, int n_in, void* d_out, int out_size, void* d_ws, size_t ws_size, hipStream_t stream) {
    static int grid = 0;
    if (grid == 0) {
        if (n_in != 18 || in_sizes[0] != M * DM || out_size != M * DM || ws_size < WS_END) { fprintf(stderr, "kernel_launch: unexpected shapes (n_in %d, in0 %d, out %d, ws %zu)\n", n_in, n_in > 0 ? in_sizes[0] : -1, out_size, ws_size); grid = -1; return; }
        int dev = 0, cus = 0, per_cu = 0;
        (void)hipGetDevice(&dev); (void)hipDeviceGetAttribute(&cus, hipDeviceAttributeMultiprocessorCount, dev);
        if (hipFuncSetAttribute((const void*)fwd_kernel, hipFuncAttributeMaxDynamicSharedMemorySize, LDS_BYTES) != hipSuccess) { fprintf(stderr, "kernel_launch: hipFuncSetAttribute failed\n"); grid = -1; return; }
        if (hipOccupancyMaxActiveBlocksPerMultiprocessor(&per_cu, (const void*)fwd_kernel, 512, LDS_BYTES) != hipSuccess || per_cu < 1) { fprintf(stderr, "kernel_launch: occupancy query says %d blocks/CU\n", per_cu); per_cu = 1; }
        (void)hipGetLastError();
        grid = cus;
        fprintf(stderr, "kernel_launch: grid %d (cus %d, per_cu %d)\n", grid, cus, per_cu);
    }
    if (grid < 0) return;
    (void)hipMemsetAsync((char*)d_ws + WS_CTL, 0, CTL_BYTES, stream);
    Args a{};
    for (int i = 0; i < 18; ++i) a.in[i] = (const float*)d_in[i];
    a.out = (float*)d_out; a.ws = (unsigned char*)d_ws;
    if (N_LAUNCHES == 1) {
        a.ph_lo = 0; a.ph_hi = 7;
        void* args[] = {&a};
        hipError_t e = hipLaunchCooperativeKernel((const void*)fwd_kernel, dim3(grid), dim3(512), args, LDS_BYTES, stream);
        if (e != hipSuccess) fprintf(stderr, "cooperative launch failed: %s (grid %d)\n", hipGetErrorString(e), grid);
    } else {
        for (int p = 0; p < 7; ++p) { a.ph_lo = p; a.ph_hi = p + 1; hipLaunchKernelGGL(fwd_kernel, dim3(grid), dim3(512), LDS_BYTES, stream, a); }
    }
}
```

```cpp
#include <hip/hip_runtime.h>
#include <hip/hip_cooperative_groups.h>
#include <cstdio>
#include <cstdint>
namespace cg = cooperative_groups;

namespace pg8 {
#define PG8_LAS __attribute__((address_space(3)))
typedef unsigned short bf16_t;
typedef short bf16x8 __attribute__((ext_vector_type(8)));
typedef float f32x4 __attribute__((ext_vector_type(4)));
typedef unsigned u32x4 __attribute__((ext_vector_type(4)));
constexpr int BM = 256, BK = 64, HALF = 128, HTB = HALF * BK * 2  , STAGE_BYTES = 8 * HTB, NXCD = 8, WGM = 8;

__host__ __device__ __forceinline__ int lds_byte(int r, int c) { const int st = (r >> 4) * 2 + (c >> 5), rr = r & 15, cc = c & 31, ob = rr * 64 + cc * 2; return st * 1024 + (ob ^ (((ob >> 9) & 1) << 5)); }
__host__ __device__ __forceinline__ void stage_rc(int b, int& R, int& C) { const int st = b / 1024, sb = b % 1024, swz = sb ^ (((sb >> 9) & 1) << 5); R = (st >> 1) * 16 + swz / 64; C = (st & 1) * 32 + (swz % 64) / 2; }
__host__ __device__ __forceinline__ int perm32(int rho) { const int n = rho >> 4, i = rho & 15; return 8 * (i >> 2) + 4 * n + (i & 3); }

struct Unit { int pm, pn; };
struct Gemm { const bf16_t* A; const bf16_t* Bt; int M, N, K; };

struct StaticOrder {
    int nM, nN, nwg, G, c;
    __host__ __device__ void init(int M, int N, int G_, int c_) { nM = M / BM; nN = N / BM; nwg = nM * nN; G = G_; c = c_; }
    __host__ __device__ bool next(int i, Unit& u) const {
        const long L = (long)i * G + c; if (L >= nwg) return false;
        int wgid = (int)L; { const int q = nwg / NXCD, r = nwg % NXCD, xcd = wgid % NXCD, off = wgid / NXCD; wgid = (xcd < r ? xcd * (q + 1) : r * (q + 1) + (xcd - r) * q) + off; }
        const int nig = WGM * nN, gid = wgid / nig, fm = gid * WGM, gsz = (nM - fm) < WGM ? (nM - fm) : WGM;
        u.pm = fm + ((wgid % nig) % gsz); u.pn = (wgid % nig) / gsz; return true;
    }
    __device__ __forceinline__ void a_ready(const Unit&) const {}
    __device__ __forceinline__ void done(const Unit&) const {}
};

__device__ __forceinline__ unsigned cvt_pk_bf16(float lo, float hi) { unsigned r; asm volatile("v_cvt_pk_bf16_f32 %0, %1, %2" : "=v"(r) : "v"(lo), "v"(hi)); return r; }
typedef float f32x2 __attribute__((ext_vector_type(2)));
__device__ __forceinline__ f32x2 gelu_pk(f32x2 v) {
    const f32x2 av = __builtin_elementwise_abs(v), d = av * 0.2316418882f + 1.0f;
    f32x2 t; t.x = __builtin_amdgcn_rcpf(d.x); t.y = __builtin_amdgcn_rcpf(d.y);
    f32x2 q = t * 0.5307027145f + (-0.7265760135f); q = q * t + 0.7107068705f; q = q * t + (-0.142248368f); q = q * t + 0.127414796f; q = q * t;
    const f32x2 s = (v * v) * (-0.72134752044f);
    f32x2 e; e.x = __builtin_amdgcn_exp2f(s.x); e.y = __builtin_amdgcn_exp2f(s.y);
    const f32x2 m = v * (q * e), r = v - m;
    f32x2 o; o.x = v.x < 0.f ? m.x : r.x; o.y = v.y < 0.f ? m.y : r.y; return o;
}

template <int ACT  > struct EpiBf16 {
    static constexpr bool PERM = true, AFTER_DRAIN = false; static_assert(ACT == 0 || ACT == 1, "EpiBf16: ACT is 0 (none) or 1 (gelu_pk)");
    bf16_t* O; int ldc; const float* bias; int split_cols; size_t split_stride; float scale0;
    __device__ __forceinline__ void operator()(const f32x4 (&acc)[2][2][4][2], const Unit& u, int wr, int wc, int fr, int fq) const {
        const int row0 = u.pm * BM + wr * 64 + fr; int colt = u.pn * BM; bf16_t* base = O;
        float sc = 1.f; if (split_cols) { const int t = colt / split_cols; base += (size_t)t * split_stride; colt -= t * split_cols; if (t == 0) sc = scale0; }
        const int col0 = colt + wc * 32 + 8 * fq, bcol0 = u.pn * BM + wc * 32 + 8 * fq;
        f32x4 bv[2][2];
#pragma unroll
        for (int bj = 0; bj < 2; ++bj)
#pragma unroll
            for (int n = 0; n < 2; ++n) bv[bj][n] = bias ? *(const f32x4*)(bias + bcol0 + bj * HALF + 4 * n) : (f32x4){0.f, 0.f, 0.f, 0.f};
#pragma unroll
        for (int ai = 0; ai < 2; ++ai)
#pragma unroll
            for (int m = 0; m < 4; ++m) { bf16_t* rowp = base + (size_t)(row0 + ai * HALF + m * 16) * ldc + col0;
#pragma unroll
                for (int bj = 0; bj < 2; ++bj) { f32x4 v0 = acc[ai][bj][m][0] + bv[bj][0], v1 = acc[ai][bj][m][1] + bv[bj][1];
                    if (ACT == 1) { f32x2 a = gelu_pk((f32x2){v0[0], v0[1]}), b = gelu_pk((f32x2){v0[2], v0[3]}), c = gelu_pk((f32x2){v1[0], v1[1]}), d = gelu_pk((f32x2){v1[2], v1[3]});
                        v0 = (f32x4){a.x, a.y, b.x, b.y}; v1 = (f32x4){c.x, c.y, d.x, d.y}; }
                    v0 = v0 * sc; v1 = v1 * sc; u32x4 w; w.x = cvt_pk_bf16(v0[0], v0[1]); w.y = cvt_pk_bf16(v0[2], v0[3]); w.z = cvt_pk_bf16(v1[0], v1[1]); w.w = cvt_pk_bf16(v1[2], v1[3]);
                    *(u32x4*)(rowp + bj * HALF) = w; } }
    }
};

template <class Epi, class Sched, bool ALIGN_EPI = false, bool SP2 = false>
__device__ __forceinline__ void gemm_phase(PG8_LAS unsigned char* lds, const Gemm g, const Sched& S, const Epi& E) {
    const int tid = threadIdx.x, wid = __builtin_amdgcn_readfirstlane(tid >> 6), lane = tid & 63, wr = wid >> 2, wc = wid & 3, fr = lane & 15, fq = lane >> 4;
    const int K = g.K, nt = K / BK;
    unsigned voffA[2], voffB[2];
#pragma unroll
    for (int i = 0; i < 2; ++i) { int R, C; stage_rc(tid * 16 + i * 8192, R, C); const int Rb = Epi::PERM ? ((R & ~31) + perm32(R & 31)) : R;
        voffA[i] = (unsigned)(R * K + C) * 2u; voffB[i] = (unsigned)(Rb * K + C) * 2u; }
    const size_t kstep = (size_t)(BK * 2);
    const size_t hstep = (size_t)HALF * K * 2;
    const size_t tstep = 2 * hstep;
    const unsigned ldsw = (unsigned)wid * 1024u;
    const int aoff = lds_byte(wr * 64 + fr, fq * 8), boff = lds_byte(wc * 32 + fr, fq * 8);
#define PG8_SA(b, h) (((b) * 2 + (h)) * HTB)
#define PG8_SB(b, h) ((4 + (b) * 2 + (h)) * HTB)
#define PG8_STAGE(bufoff, gbase, voff) do { _Pragma("unroll") for (int _i = 0; _i < 2; ++_i) \
        __builtin_amdgcn_global_load_lds((const unsigned*)((const char*)(gbase) + (voff)[_i]), (PG8_LAS unsigned*)(lds + (bufoff) + ldsw + _i * 8192), 16, 0, 0); } while (0)
#define PG8_LDA(dst, b, h) do { _Pragma("unroll") for (int m = 0; m < 4; ++m) _Pragma("unroll") for (int k = 0; k < 2; ++k) dst[m][k] = *(const PG8_LAS bf16x8*)(lds + PG8_SA(b, h) + aoff + m * 2048 + k * 1024); } while (0)
#define PG8_LDB(dst, b, h) do { _Pragma("unroll") for (int n = 0; n < 2; ++n) _Pragma("unroll") for (int k = 0; k < 2; ++k) dst[n][k] = *(const PG8_LAS bf16x8*)(lds + PG8_SB(b, h) + boff + n * 2048 + k * 1024); } while (0)
#define PG8_MMA(ai, bj, At, Bt) do { __builtin_amdgcn_s_setprio(1); _Pragma("unroll") for (int m = 0; m < 4; ++m) _Pragma("unroll") for (int n = 0; n < 2; ++n) _Pragma("unroll") for (int k = 0; k < 2; ++k) \
        acc[ai][bj][m][n] = __builtin_amdgcn_mfma_f32_16x16x32_bf16(Bt[n][k], At[m][k], acc[ai][bj][m][n], 0, 0, 0); __builtin_amdgcn_s_setprio(0); } while (0)
#define PG8_WAIT_V(n) asm volatile("s_waitcnt vmcnt(" #n ")" ::: "memory")
#define PG8_WAIT_L(n) asm volatile("s_waitcnt lgkmcnt(" #n ")" ::: "memory")
#define PG8_BAR __builtin_amdgcn_s_barrier()
#define PG8_SCHED __builtin_amdgcn_sched_barrier(0)
    Unit cur, nxt; int ui = 0;
    if (!S.next(0, cur)) return;
    f32x4 acc[2][2][4][2];
#pragma unroll
    for (int a = 0; a < 2; ++a)
#pragma unroll
        for (int b = 0; b < 2; ++b)
#pragma unroll
            for (int m = 0; m < 4; ++m)
#pragma unroll
                for (int n = 0; n < 2; ++n) acc[a][b][m][n] = (f32x4){0.f, 0.f, 0.f, 0.f};
    bf16x8 At[4][2], B0[2][2], B1[2][2];
    const char* cA = (const char*)g.A + (size_t)cur.pm * tstep; const char* cB = (const char*)g.Bt + (size_t)cur.pn * tstep;
    S.a_ready(cur);
    if constexpr (SP2) {
        PG8_STAGE(PG8_SB(0, 0), cB, voffB); PG8_STAGE(PG8_SB(0, 1), cB + hstep, voffB); PG8_STAGE(PG8_SA(0, 0), cA, voffA); PG8_STAGE(PG8_SA(0, 1), cA + hstep, voffA);
        if (wr == 1) PG8_BAR;
        PG8_WAIT_V(2); PG8_BAR;
        PG8_STAGE(PG8_SB(1, 0), cB + kstep, voffB); PG8_STAGE(PG8_SA(1, 0), cA + kstep, voffA); PG8_STAGE(PG8_SB(1, 1), cB + hstep + kstep, voffB);
        PG8_WAIT_V(6); PG8_BAR;
    } else {
        PG8_STAGE(PG8_SB(0, 0), cB, voffB); PG8_STAGE(PG8_SA(0, 0), cA, voffA); PG8_STAGE(PG8_SB(0, 1), cB + hstep, voffB); PG8_STAGE(PG8_SA(0, 1), cA + hstep, voffA);
        if (wr == 1) PG8_BAR;
        PG8_WAIT_V(4); PG8_BAR;
        PG8_STAGE(PG8_SB(1, 0), cB + kstep, voffB); PG8_STAGE(PG8_SA(1, 0), cA + kstep, voffA); PG8_STAGE(PG8_SB(1, 1), cB + hstep + kstep, voffB);
        PG8_WAIT_V(6); PG8_BAR;
    }
    for (;;) {
        const bool has_next = S.next(ui + 1, nxt);
        const char* nA = has_next ? (const char*)g.A + (size_t)nxt.pm * tstep : cA; const char* nB = has_next ? (const char*)g.Bt + (size_t)nxt.pn * tstep : cB;
        for (int t = 0; t < nt; t += 2) {
            const bool last = (t == nt - 2);
            const char* a1 = cA + (size_t)(t + 1) * kstep;
            const char* a2 = last ? nA : cA + (size_t)(t + 2) * kstep; const char* b2 = last ? nB : cB + (size_t)(t + 2) * kstep;
            const char* a3 = a2 + kstep; const char* b3 = b2 + kstep;
            if (last && has_next) S.a_ready(nxt);
            if constexpr (SP2) {
            PG8_LDB(B0, 0, 0); PG8_LDB(B1, 0, 1); PG8_SCHED; PG8_LDA(At, 0, 0); PG8_STAGE(PG8_SA(1, 1), a1 + hstep, voffA);
            PG8_WAIT_V(8); PG8_WAIT_L(0); PG8_BAR; PG8_MMA(0, 0, At, B0); PG8_MMA(0, 1, At, B1); PG8_BAR; PG8_SCHED;
            PG8_LDA(At, 0, 1); PG8_STAGE(PG8_SB(0, 0), b2, voffB); PG8_STAGE(PG8_SB(0, 1), b2 + hstep, voffB); PG8_STAGE(PG8_SA(0, 0), a2, voffA);
            PG8_WAIT_V(8); PG8_WAIT_L(0); PG8_BAR; PG8_MMA(1, 0, At, B0); PG8_MMA(1, 1, At, B1); PG8_BAR; PG8_SCHED;
            PG8_LDB(B0, 1, 0); PG8_LDB(B1, 1, 1); PG8_SCHED; PG8_LDA(At, 1, 0); PG8_STAGE(PG8_SA(0, 1), a2 + hstep, voffA);
            PG8_WAIT_V(8); PG8_WAIT_L(0); PG8_BAR; PG8_MMA(0, 0, At, B0); PG8_MMA(0, 1, At, B1); PG8_BAR; PG8_SCHED;
            PG8_LDA(At, 1, 1); PG8_STAGE(PG8_SB(1, 0), b3, voffB); PG8_STAGE(PG8_SB(1, 1), b3 + hstep, voffB); PG8_STAGE(PG8_SA(1, 0), a3, voffA);
            PG8_WAIT_V(8); PG8_WAIT_L(0); PG8_BAR; PG8_MMA(1, 0, At, B0); PG8_MMA(1, 1, At, B1); PG8_BAR; PG8_SCHED;
            } else {
            PG8_LDB(B0, 0, 0); PG8_SCHED; PG8_LDA(At, 0, 0); PG8_STAGE(PG8_SA(1, 1), a1 + hstep, voffA);
            PG8_WAIT_L(8); PG8_BAR; PG8_WAIT_L(0); PG8_MMA(0, 0, At, B0); PG8_BAR; PG8_SCHED;
            PG8_LDB(B1, 0, 1); PG8_STAGE(PG8_SB(0, 0), b2, voffB);
            PG8_BAR; PG8_WAIT_L(0); PG8_MMA(0, 1, At, B1); PG8_BAR;
            PG8_LDA(At, 0, 1); PG8_STAGE(PG8_SA(0, 0), a2, voffA);
            PG8_BAR; PG8_WAIT_L(0); PG8_MMA(1, 0, At, B0); PG8_BAR; PG8_SCHED;
            PG8_STAGE(PG8_SB(0, 1), b2 + hstep, voffB);
            PG8_WAIT_V(6); PG8_BAR; PG8_MMA(1, 1, At, B1); PG8_BAR;
            PG8_LDB(B0, 1, 0); PG8_SCHED; PG8_LDA(At, 1, 0); PG8_STAGE(PG8_SA(0, 1), a2 + hstep, voffA);
            PG8_WAIT_L(8); PG8_BAR; PG8_WAIT_L(0); PG8_MMA(0, 0, At, B0); PG8_BAR; PG8_SCHED;
            PG8_LDB(B1, 1, 1); PG8_STAGE(PG8_SB(1, 0), b3, voffB);
            PG8_BAR; PG8_WAIT_L(0); PG8_MMA(0, 1, At, B1); PG8_BAR;
            PG8_LDA(At, 1, 1); PG8_STAGE(PG8_SA(1, 0), a3, voffA);
            PG8_BAR; PG8_WAIT_L(0); PG8_MMA(1, 0, At, B0); PG8_BAR; PG8_SCHED;
            PG8_STAGE(PG8_SB(1, 1), b3 + hstep, voffB);
            PG8_WAIT_V(6); PG8_BAR; PG8_MMA(1, 1, At, B1); PG8_BAR;
            }
        }
        if constexpr (ALIGN_EPI) { if (wr == 0) PG8_BAR; }
        if constexpr (!Epi::AFTER_DRAIN) { E(acc, cur, wr, wc, fr, fq); S.done(cur); }
        if (!has_next) break;
#pragma unroll
        for (int a = 0; a < 2; ++a)
#pragma unroll
            for (int b = 0; b < 2; ++b)
#pragma unroll
                for (int m = 0; m < 4; ++m)
#pragma unroll
                    for (int n = 0; n < 2; ++n) acc[a][b][m][n] = (f32x4){0.f, 0.f, 0.f, 0.f};
        cur = nxt; cA = nA; cB = nB; ++ui;
        if constexpr (ALIGN_EPI) { if (wr == 1) PG8_BAR; }
    }
    PG8_WAIT_V(0);
    if constexpr (!ALIGN_EPI) { if (wr == 0) PG8_BAR; }
    PG8_BAR;
    if constexpr (Epi::AFTER_DRAIN) { E.fused(acc, cur, wr, wc, fr, fq, lds, wid, lane); S.done(cur); }
#undef PG8_SA
#undef PG8_SB
#undef PG8_STAGE
#undef PG8_LDA
#undef PG8_LDB
#undef PG8_MMA
#undef PG8_WAIT_V
#undef PG8_WAIT_L
#undef PG8_BAR
#undef PG8_SCHED
}
}


constexpr int NB = 16, T = 2048, DM = 1024, M = NB * T;
constexpr int UP = 3840;
constexpr int C_QA = 0, C_KA = 512, C_VA = 1024, C_ZA = 1536, C_QB = 2048, C_KC = 2560, C_VC = 2688, C_KS = 2816, C_VS = 2944, C_KW = 3072, C_VW = 3200, C_ZB = 3328;
constexpr int DIN_SRC = 3852, GATE_SRC = 3328;
constexpr int NCMP = 127;
constexpr float LOG2E = 1.4426950408889634f;
constexpr float QA_SCALE = 0.125f * LOG2E;
constexpr float QB_SCALE = 0.08838834764831845f * LOG2E;
constexpr float NORM_EPS = 1e-6f;
constexpr float LAM_INIT = 0.2f;

constexpr size_t MiB = 1u << 20;
constexpr size_t WS_CTL = 0;
constexpr size_t WS_WIN = 2 * MiB;
constexpr size_t WS_WOUT = 10 * MiB;
constexpr size_t WS_WK1 = 12 * MiB, WS_WV1 = 13 * MiB;
constexpr size_t WS_WK2 = 14 * MiB, WS_WV2 = 14 * MiB + 65536;
constexpr size_t WS_MOD = 15 * MiB;
constexpr size_t WS_B1P = 15 * MiB + 524288;
constexpr size_t WS_KCMP = 16 * MiB, WS_VCMP = 16 * MiB + 524288;
constexpr size_t WS_GATES = 18 * MiB;
constexpr size_t WS_H = 32 * MiB;
constexpr size_t WS_Y = 32 * MiB;
constexpr size_t WS_U = 96 * MiB;
constexpr size_t WS_CAT = 336 * MiB;
constexpr size_t WS_NSAACC = 400 * MiB;
constexpr size_t WS_END = 432 * MiB;
constexpr int CTL_BYTES = 4096 + 16384;
constexpr int CW_BAR = 1024;
constexpr int CW_Q3 = 0, CW_Q4 = 64;

constexpr int LDS_BYTES = 147456;
constexpr int KSTR = 272, VSTR = 320;
constexpr int KT_BYTES = 64 * KSTR, VT_BYTES = 64 * VSTR, BUF_BYTES = KT_BYTES + VT_BYTES;
constexpr int L_BUF0 = 0, L_BUF1 = BUF_BYTES, L_XCH = 77824, L_MISC = 143360;
static_assert(2 * BUF_BYTES <= L_XCH && L_XCH + 65536 <= L_MISC && L_MISC + 4096 <= LDS_BYTES, "LDS map");

#define LAS __attribute__((address_space(3)))
typedef unsigned short bf16;
typedef short bf16x8 __attribute__((ext_vector_type(8)));
typedef short s16x4 __attribute__((ext_vector_type(4)));
typedef float f32x4 __attribute__((ext_vector_type(4)));
typedef float f32x16 __attribute__((ext_vector_type(16)));
typedef unsigned u32x4 __attribute__((ext_vector_type(4)));
typedef unsigned u32x2 __attribute__((ext_vector_type(2)));
typedef float f32x2_t __attribute__((ext_vector_type(2)));
typedef __bf16 bf16x2_t __attribute__((ext_vector_type(2)));

__device__ __forceinline__ unsigned pk2(float lo, float hi) { f32x2_t v = {lo, hi}; bf16x2_t b = __builtin_convertvector(v, bf16x2_t); return __builtin_bit_cast(unsigned, b); }
__device__ __forceinline__ float bf2f(unsigned short u) { return __uint_as_float((unsigned)u << 16); }
__device__ __forceinline__ float bflo(unsigned w) { return __uint_as_float(w << 16); }
__device__ __forceinline__ float bfhi(unsigned w) { return __uint_as_float(w & 0xffff0000u); }
__device__ __forceinline__ float wave_sum(float v) {
#pragma unroll
    for (int o = 1; o < 64; o <<= 1) v += __shfl_xor(v, o);
    return v;
}
__device__ __forceinline__ float xhalf_max(float v) { auto rr = __builtin_amdgcn_permlane32_swap(__float_as_uint(v), __float_as_uint(v), false, false); return fmaxf(__uint_as_float(rr[0]), __uint_as_float(rr[1])); }
__device__ __forceinline__ float xhalf_sum(float v) { auto rr = __builtin_amdgcn_permlane32_swap(__float_as_uint(v), __float_as_uint(v), false, false); return __uint_as_float(rr[0]) + __uint_as_float(rr[1]); }
__device__ __forceinline__ float silu_f(float v) { return v / (1.f + __expf(-v)); }
__device__ __forceinline__ float sigmoid_f(float v) { return 1.f / (1.f + __expf(-v)); }
__device__ __forceinline__ float gelu_tanh(float x) { const float u = 0.7978845608028654f * (x + 0.044715f * x * x * x); const float e = __expf(2.f * u); const float th = 1.f - 2.f / (1.f + e); return 0.5f * x * (1.f + th); }
__device__ __forceinline__ int crow(int r, int hi) { return (r & 3) + 8 * (r >> 2) + 4 * hi; }
__device__ __forceinline__ bf16x8 pack8(const f32x16& p, int b0) {
    u32x4 w = {pk2(p[b0 + 0], p[b0 + 1]), pk2(p[b0 + 2], p[b0 + 3]), pk2(p[b0 + 4], p[b0 + 5]), pk2(p[b0 + 6], p[b0 + 7])};
    return __builtin_bit_cast(bf16x8, w);
}
typedef short v4i16_t __attribute__((ext_vector_type(4)));
__device__ __forceinline__ s16x4 vtr(LAS const unsigned char* p) { return __builtin_bit_cast(s16x4, __builtin_amdgcn_ds_read_tr16_b64_v4i16((LAS v4i16_t*)p)); }
#define MFMA32(a, b, c) __builtin_amdgcn_mfma_f32_32x32x16_bf16((a), (b), (c), 0, 0, 0)

#define XB_TMO      128
#define XB_XCNT(j)  (256  + 64 * (j))
#define XB_XSUB(j)  (1280 + 64 * (j))
#define XB_XGEN(j)  (2304 + 64 * (j))
#define XB_TOP      3328
#define XB_TOPGEN   3392
#define XCD_BAR_WORDS 3456
#define XB_SPIN_CAP (1u << 18)

__device__ __forceinline__ unsigned xb_ld(unsigned* p)              { return __hip_atomic_load(p, __ATOMIC_RELAXED, __HIP_MEMORY_SCOPE_AGENT); }
__device__ __forceinline__ unsigned xb_add(unsigned* p, unsigned v) { return __hip_atomic_fetch_add(p, v, __ATOMIC_RELAXED, __HIP_MEMORY_SCOPE_AGENT); }
__device__ __forceinline__ unsigned xb_xcc_id() { return (unsigned)__builtin_amdgcn_s_getreg((3 << 11) | 20) & 0xFu; }
#define XB_SPIN(cond, bar) do { unsigned _sp = 0; while (cond) { __builtin_amdgcn_s_sleep(1); \
    if ((++_sp & 255u) == 0u) { if (xb_ld(&(bar)[XB_TMO])) break; if (_sp > XB_SPIN_CAP) { atomicAdd(&(bar)[XB_TMO], 1u); break; } } } } while (0)

struct XcdBarrier {
    unsigned* bar; unsigned x;
    volatile LAS unsigned* st;
};

__device__ __forceinline__ XcdBarrier xcd_barrier_post(unsigned* bar, volatile LAS unsigned* st) {
    XcdBarrier b; b.bar = bar; b.x = xb_xcc_id(); b.st = st;
    if (threadIdx.x == 0) (void)xb_add(&bar[XB_XCNT(b.x)], 1u);
    return b;
}
__device__ __forceinline__ void xcd_barrier_complete(unsigned* bar, unsigned x, unsigned& nloc, unsigned& nx) {
    const unsigned G = gridDim.x * gridDim.y * gridDim.z;
    unsigned sum, cnt, mine, sp = 0u;
    for (;;) {
        sum = 0u; cnt = 0u; mine = 0u;
#pragma unroll
        for (unsigned j = 0; j < 16; ++j) { const unsigned c = xb_ld(&bar[XB_XCNT(j)]); sum += c; cnt += (c > 0u) ? 1u : 0u; mine = (j == x) ? c : mine; }
        if (sum == G) break;
        __builtin_amdgcn_s_sleep(1);
        if ((++sp & 255u) == 0u) { if (xb_ld(&bar[XB_TMO])) break; if (sp > XB_SPIN_CAP) { atomicAdd(&bar[XB_TMO], 1u); break; } }
    }
    nloc = mine > 0u ? mine : 1u; nx = cnt > 0u ? cnt : 1u;
}

__device__ __forceinline__ void xcd_barrier(const XcdBarrier& b) {
    asm volatile("s_waitcnt vmcnt(0)" ::: "memory");
    __syncthreads();
    if (threadIdx.x == 0) {
        unsigned* bar = b.bar;
        __builtin_amdgcn_s_waitcnt(0);
        unsigned nloc = b.st[0], nx = b.st[1];
        if (nloc == 0u) { xcd_barrier_complete(bar, b.x, nloc, nx); b.st[0] = nloc; b.st[1] = nx; }
        const unsigned old = xb_add(&bar[XB_XSUB(b.x)], 1u);
        const unsigned gen = old / nloc;
        if (old + 1u == (gen + 1u) * nloc) {
            __builtin_amdgcn_fence(__ATOMIC_RELEASE, "agent");
            asm volatile("s_waitcnt vmcnt(0)" ::: "memory");
            const unsigned og = xb_add(&bar[XB_TOP], 1u);
            const unsigned tg = og / nx;
            if (og + 1u == (tg + 1u) * nx) xb_add(&bar[XB_TOPGEN], 1u);
            else XB_SPIN(xb_ld(&bar[XB_TOPGEN]) == tg, bar);
            __builtin_amdgcn_fence(__ATOMIC_ACQUIRE, "agent");
            xb_add(&bar[XB_XGEN(b.x)], 1u);
            asm volatile("s_waitcnt vmcnt(0)" ::: "memory");
        } else {
            XB_SPIN(xb_ld(&bar[XB_XGEN(b.x)]) == gen, bar);
            __builtin_amdgcn_fence(__ATOMIC_ACQUIRE, "agent");
            asm volatile("s_waitcnt vmcnt(0)" ::: "memory");
        }
    }
    __syncthreads();
}


struct Args {
    const float* in[18]; float* out; unsigned char* ws; int ph_lo, ph_hi;
};

struct Ctx {
    LAS unsigned char* lds;
    unsigned char* ws;
    int tid, lane, wave, G, bid;
};

__device__ __forceinline__ void transpose_item(const float* W, int K, int Nsrc, int Ndst, bf16* WT, LAS float* scr, int item, int lane, int mode) {
    const int nblk = Ndst / 32, kb = item / nblk, nb = item % nblk, k0 = 64 * kb, n0 = 32 * nb;
    int s0 = n0; float sc = 1.f;
    if (mode == 1) { if (n0 >= GATE_SRC) s0 = n0 + 12; if (n0 < 512) sc = QA_SCALE; else if (n0 >= C_QB && n0 < C_QB + 512) sc = QB_SCALE; }
    const int ksub = lane >> 3, c4 = lane & 7;
    f32x4 v[8];
#pragma unroll
    for (int i = 0; i < 8; ++i) v[i] = *(const f32x4*)(W + (size_t)(k0 + 8 * i + ksub) * Nsrc + s0 + 4 * c4);
#pragma unroll
    for (int i = 0; i < 8; ++i) { LAS float* d = scr + (8 * i + ksub) * 33 + 4 * c4; d[0] = v[i].x * sc; d[1] = v[i].y * sc; d[2] = v[i].z * sc; d[3] = v[i].w * sc; }
    asm volatile("s_waitcnt lgkmcnt(0)" ::: "memory");
    const int c = lane & 7;
#pragma unroll
    for (int j = 0; j < 4; ++j) { const int n = (lane >> 3) + 8 * j; const LAS float* sp = scr + (8 * c) * 33 + n;
        u32x4 o; o.x = pk2(sp[0 * 33], sp[1 * 33]); o.y = pk2(sp[2 * 33], sp[3 * 33]); o.z = pk2(sp[4 * 33], sp[5 * 33]); o.w = pk2(sp[6 * 33], sp[7 * 33]);
        *(u32x4*)(WT + (size_t)(n0 + n) * K + k0 + 8 * c) = o; }
    asm volatile("s_waitcnt lgkmcnt(0)" ::: "memory");
}

__device__ __forceinline__ void p0_prologue(const Ctx& X, const Args& a) {
    const float* c_in = a.in[1]; const float* w_ada = a.in[2]; const float* b_ada = a.in[3];
    const float* w_in = a.in[6]; const float* w_out = a.in[7]; const float* cmp_pos = a.in[13];
    const float* wk1 = a.in[14]; const float* wk2 = a.in[15]; const float* wv1 = a.in[16]; const float* wv2 = a.in[17];
    if (X.bid < 96) {
        LAS float* cond = (LAS float*)(X.lds);
        LAS float* red = (LAS float*)(X.lds + 65536);
        const int j0 = 32 * X.bid, cg4 = X.lane & 7, ks = X.lane >> 3;
        f32x4 wva[16];
#pragma unroll
        for (int it = 0; it < 16; ++it) wva[it] = *(const f32x4*)(w_ada + (size_t)(128 * X.wave + 8 * it + ks) * 3072 + j0 + 4 * cg4);
        { f32x4 cv[8];
#pragma unroll
          for (int i = 0; i < 8; ++i) cv[i] = *(const f32x4*)(c_in + 4 * (X.tid + 512 * i));
#pragma unroll
          for (int i = 0; i < 8; ++i) { const int e = 4 * (X.tid + 512 * i), b = e >> 10, k = e & 1023;
              cond[k * 16 + b] = silu_f(cv[i].x); cond[(k + 1) * 16 + b] = silu_f(cv[i].y); cond[(k + 2) * 16 + b] = silu_f(cv[i].z); cond[(k + 3) * 16 + b] = silu_f(cv[i].w); } }
        __syncthreads();
        float acc[4][16];
#pragma unroll
        for (int c = 0; c < 4; ++c)
#pragma unroll
            for (int b = 0; b < 16; ++b) acc[c][b] = 0.f;
#pragma unroll
        for (int it = 0; it < 16; ++it) {
            const int k = 128 * X.wave + 8 * it + ks;
            const f32x4 wv = wva[it];
            const LAS f32x4* cp = (const LAS f32x4*)(cond + k * 16);
#pragma unroll
            for (int b4 = 0; b4 < 4; ++b4) { const f32x4 cv = cp[b4];
#pragma unroll
                for (int bb = 0; bb < 4; ++bb)
#pragma unroll
                    for (int c = 0; c < 4; ++c) acc[c][b4 * 4 + bb] += wv[c] * cv[bb]; }
        }
#pragma unroll
        for (int c = 0; c < 4; ++c)
#pragma unroll
            for (int b = 0; b < 16; ++b) { float v = acc[c][b]; v += __shfl_xor(v, 8); v += __shfl_xor(v, 16); v += __shfl_xor(v, 32); acc[c][b] = v; }
        if (ks == 0) {
#pragma unroll
            for (int c = 0; c < 4; ++c)
#pragma unroll
                for (int b = 0; b < 16; ++b) red[(X.wave * 32 + 4 * cg4 + c) * 16 + b] = acc[c][b];
        }
        __syncthreads();
        { const int col = X.tid >> 4, b = X.tid & 15; float s = 0.f;
#pragma unroll
          for (int w = 0; w < 8; ++w) s += red[(w * 32 + col) * 16 + b];
          float* mod = (float*)(X.ws + WS_MOD);
          mod[b * 3072 + j0 + col] = s + b_ada[j0 + col]; }
        __syncthreads();
    }
    LAS float* scr = (LAS float*)(X.lds + X.wave * 16384);
    const bool split = X.G > 192;
    if (split && X.bid < 96) return;
    const int gw = (split ? X.bid - 96 : X.bid) * 8 + X.wave, NGW = (split ? X.G - 96 : X.G) * 8;
    constexpr int I_IN = 16 * 120, I_OUT = 16 * 32, I_C1 = 64 * 4, I_C2 = 2 * 4, I_B1 = 128;
    constexpr int NITEMS = I_IN + I_OUT + 2 * I_C1 + 2 * I_C2 + I_B1;
    for (int it = gw; it < NITEMS; it += NGW) {
        int r = it;
        if (r < I_IN) { transpose_item(w_in, 1024, DIN_SRC, UP, (bf16*)(X.ws + WS_WIN), scr, r, X.lane, 1); continue; } r -= I_IN;
        if (r < I_OUT) { transpose_item(w_out, 1024, 1024, 1024, (bf16*)(X.ws + WS_WOUT), scr, r, X.lane, 0); continue; } r -= I_OUT;
        if (r < I_C1) { transpose_item(wk1, 4096, 128, 128, (bf16*)(X.ws + WS_WK1), scr, r, X.lane, 0); continue; } r -= I_C1;
        if (r < I_C1) { transpose_item(wv1, 4096, 128, 128, (bf16*)(X.ws + WS_WV1), scr, r, X.lane, 0); continue; } r -= I_C1;
        if (r < I_C2) { transpose_item(wk2, 128, 128, 128, (bf16*)(X.ws + WS_WK2), scr, r, X.lane, 0); continue; } r -= I_C2;
        if (r < I_C2) { transpose_item(wv2, 128, 128, 128, (bf16*)(X.ws + WS_WV2), scr, r, X.lane, 0); continue; } r -= I_C2;
        {
            const int kv = r >> 6, p = r & 63; const float* w1 = kv ? wv1 : wk1;
            const int n4 = X.lane & 31, kh = X.lane >> 5;
            f32x4 acc = {0.f, 0.f, 0.f, 0.f};
#pragma unroll 16
            for (int i = 0; i < 32; ++i) { const int k = 64 * p + 2 * i + kh; const float pv = cmp_pos[k]; const f32x4 wv = *(const f32x4*)(w1 + (size_t)k * 128 + 4 * n4); acc = acc + wv * pv; }
            acc.x += __shfl_xor(acc.x, 32); acc.y += __shfl_xor(acc.y, 32); acc.z += __shfl_xor(acc.z, 32); acc.w += __shfl_xor(acc.w, 32);
            if (kh == 0) *(f32x4*)((float*)(X.ws + WS_B1P) + (kv * 64 + p) * 128 + 4 * n4) = acc;
        }
    }
}

__device__ __forceinline__ void p1_norm(const Ctx& X, const Args& a) {
    const float* x = a.in[0]; const float* g_pre = a.in[4]; const float* w_in = a.in[6];
    const float* mod = (const float*)(X.ws + WS_MOD);
    bf16* H = (bf16*)(X.ws + WS_H); float* G = (float*)(X.ws + WS_GATES);
    LAS float* Wg = (LAS float*)X.lds;
    for (int k = X.tid; k < 1024; k += 512) {
        const f32x4* src = (const f32x4*)(w_in + (size_t)k * DIN_SRC + GATE_SRC);
        LAS f32x4* dst = (LAS f32x4*)(Wg + k * 12); dst[0] = src[0]; dst[1] = src[1]; dst[2] = src[2];
    }
    __syncthreads();
    const int gw = X.bid * 8 + X.wave, NGW = X.G * 8;
    for (int grp = gw; grp < M / 16; grp += NGW) {
        const int row0 = grp * 16, b = row0 / T;
        f32x4 gs[4], sh[4];
#pragma unroll
        for (int j = 0; j < 4; ++j) { const int k = 256 * j + 4 * X.lane;
            const f32x4 g = *(const f32x4*)(g_pre + k), sc = *(const f32x4*)(mod + b * 3072 + 1024 + k); sh[j] = *(const f32x4*)(mod + b * 3072 + k);
            gs[j] = g * (1.f + sc); }
        constexpr int RP = 2;
        for (int ps = 0; ps < 16 / RP; ++ps) {
            asm volatile("" ::: "memory");
            f32x4 xv[RP][4]; float rs[RP];
#pragma unroll
            for (int r = 0; r < RP; ++r) { const float* xr = x + (size_t)(row0 + RP * ps + r) * DM + 4 * X.lane; float s = 0.f;
#pragma unroll
                for (int j = 0; j < 4; ++j) { xv[r][j] = *(const f32x4*)(xr + 256 * j); const f32x4 v = xv[r][j]; s += (v.x * v.x + v.y * v.y) + (v.z * v.z + v.w * v.w); }
                rs[r] = s; }
#pragma unroll
            for (int r = 0; r < RP; ++r) rs[r] = rsqrtf(wave_sum(rs[r]) * (1.f / DM) + NORM_EPS);
            float ga[RP][12];
#pragma unroll
            for (int r = 0; r < RP; ++r)
#pragma unroll
                for (int g = 0; g < 12; ++g) ga[r][g] = 0.f;
#pragma unroll
            for (int j = 0; j < 4; ++j) {
#pragma unroll
                for (int r = 0; r < RP; ++r) { xv[r][j] = xv[r][j] * rs[r] * gs[j] + sh[j];
                    u32x2 o; o.x = pk2(xv[r][j].x, xv[r][j].y); o.y = pk2(xv[r][j].z, xv[r][j].w);
                    *(u32x2*)(H + (size_t)(row0 + RP * ps + r) * DM + 256 * j + 4 * X.lane) = o; }
#pragma unroll
                for (int e = 0; e < 4; ++e) { const LAS f32x4* wp = (const LAS f32x4*)(Wg + (256 * j + 4 * X.lane + e) * 12);
                    const f32x4 w0 = wp[0], w1 = wp[1], w2 = wp[2];
#pragma unroll
                    for (int r = 0; r < RP; ++r) { const float hv = xv[r][j][e];
                        ga[r][0] += hv * w0.x; ga[r][1] += hv * w0.y; ga[r][2] += hv * w0.z; ga[r][3] += hv * w0.w;
                        ga[r][4] += hv * w1.x; ga[r][5] += hv * w1.y; ga[r][6] += hv * w1.z; ga[r][7] += hv * w1.w;
                        ga[r][8] += hv * w2.x; ga[r][9] += hv * w2.y; ga[r][10] += hv * w2.z; ga[r][11] += hv * w2.w; } }
            }
#pragma unroll
            for (int r = 0; r < RP; ++r)
#pragma unroll
                for (int g = 0; g < 12; ++g) ga[r][g] = wave_sum(ga[r][g]);
            if (X.lane < RP * 12) { const int r = X.lane / 12, g = X.lane % 12; float v = 0.f;
#pragma unroll
                for (int rr = 0; rr < RP; ++rr)
#pragma unroll
                    for (int gg = 0; gg < 12; ++gg) if (rr == r && gg == g) v = ga[rr][gg];
                G[(size_t)(row0 + RP * ps + r) * 16 + g] = sigmoid_f(v); }
        }
    }
}

__device__ __forceinline__ void p6_final(const Ctx& X, const Args& a) {
    const float* x = a.in[0]; const float* g_post = a.in[5]; float* out = a.out;
    const float* mod = (const float*)(X.ws + WS_MOD); const bf16* Y = (const bf16*)(X.ws + WS_Y);
    const int gw = X.bid * 8 + X.wave, NGW = X.G * 8;
    for (int grp = gw; grp < M / 16; grp += NGW) {
        const int row0 = grp * 16, b = row0 / T;
        f32x4 gp[2][2];
#pragma unroll
        for (int j = 0; j < 2; ++j)
#pragma unroll
            for (int e = 0; e < 2; ++e) { const int k = 512 * j + 8 * X.lane + 4 * e; gp[j][e] = *(const f32x4*)(g_post + k) * *(const f32x4*)(mod + b * 3072 + 2048 + k); }
        for (int r = 0; r < 16; ++r) {
            const size_t ro = (size_t)(row0 + r) * DM;
            u32x4 yv[2]; f32x4 xv[2][2]; float s = 0.f;
#pragma unroll
            for (int j = 0; j < 2; ++j) { yv[j] = *(const u32x4*)(Y + ro + 512 * j + 8 * X.lane); xv[j][0] = *(const f32x4*)(x + ro + 512 * j + 8 * X.lane); xv[j][1] = *(const f32x4*)(x + ro + 512 * j + 8 * X.lane + 4); }
            f32x4 yf[2][2];
#pragma unroll
            for (int j = 0; j < 2; ++j) { yf[j][0] = (f32x4){bflo(yv[j].x), bfhi(yv[j].x), bflo(yv[j].y), bfhi(yv[j].y)}; yf[j][1] = (f32x4){bflo(yv[j].z), bfhi(yv[j].z), bflo(yv[j].w), bfhi(yv[j].w)};
#pragma unroll
                for (int e = 0; e < 2; ++e) { const f32x4 v = yf[j][e]; s += (v.x * v.x + v.y * v.y) + (v.z * v.z + v.w * v.w); } }
            const float rstd = rsqrtf(wave_sum(s) * (1.f / DM) + NORM_EPS);
#pragma unroll
            for (int j = 0; j < 2; ++j)
#pragma unroll
                for (int e = 0; e < 2; ++e) *(f32x4*)(out + ro + 512 * j + 8 * X.lane + 4 * e) = xv[j][e] + yf[j][e] * rstd * gp[j][e];
        }
    }
}

__device__ __forceinline__ void stage_load(u32x4 (&r)[4], const bf16* Kg, const bf16* Vg, int pitch, int tid) {
#pragma unroll
    for (int i = 0; i < 2; ++i) { const int c = tid + 512 * i, key = c >> 4, col = c & 15;
        r[i] = *(const u32x4*)(Kg + (size_t)key * pitch + col * 8); r[2 + i] = *(const u32x4*)(Vg + (size_t)key * pitch + col * 8); }
}
__device__ __forceinline__ void stage_store(LAS unsigned char* buf, const u32x4 (&r)[4], int tid) {
#pragma unroll
    for (int i = 0; i < 2; ++i) { const int c = tid + 512 * i, key = c >> 4, col = c & 15;
        *(LAS u32x4*)(buf + key * KSTR + col * 16) = r[i]; *(LAS u32x4*)(buf + KT_BYTES + key * VSTR + col * 16) = r[2 + i]; }
}
template <int KS>
__device__ __forceinline__ void qk_tile(f32x16& p0, f32x16& p1, LAS const unsigned char* kb, const bf16x8 (&qf)[KS]) {
#pragma unroll
    for (int r = 0; r < 16; ++r) { p0[r] = 0.f; p1[r] = 0.f; }
#pragma unroll
    for (int s = 0; s < KS; ++s) {
        const bf16x8 a0 = *(LAS const bf16x8*)(kb + s * 32), a1 = *(LAS const bf16x8*)(kb + 32 * KSTR + s * 32);
        p0 = MFMA32(a0, qf[s], p0); p1 = MFMA32(a1, qf[s], p1);
        if (s & 1) __builtin_amdgcn_sched_barrier(0);
    }
}
__device__ __forceinline__ void pv_tile(f32x16 (&o)[4], LAS const unsigned char* vb, bf16x8 pb0, bf16x8 pb1, bf16x8 pb2, bf16x8 pb3) {
#pragma unroll
    for (int db = 0; db < 4; ++db) {
        s16x4 lo[4], hi[4];
#pragma unroll
        for (int ks = 0; ks < 4; ++ks) { lo[ks] = vtr(vb + (16 * ks) * VSTR + db * 64); hi[ks] = vtr(vb + (16 * ks + 8) * VSTR + db * 64); }
#define PKV(k) (bf16x8){lo[k][0], lo[k][1], lo[k][2], lo[k][3], hi[k][0], hi[k][1], hi[k][2], hi[k][3]}
        o[db] = MFMA32(PKV(0), pb0, o[db]); o[db] = MFMA32(PKV(1), pb1, o[db]); o[db] = MFMA32(PKV(2), pb2, o[db]); o[db] = MFMA32(PKV(3), pb3, o[db]);
#undef PKV
        __builtin_amdgcn_sched_barrier(0);
    }
}

template <int KS>
__device__ __forceinline__ void attend(const Ctx& X, f32x16 (&o)[4], float& m, float& l, const bf16x8 (&qf)[KS], const bf16* Kg, const bf16* Vg, int kcolB,
                                       unsigned tilemask, int qp, int qw0, int W, unsigned selbits, float s2, int refpos) {
    const int lane = X.lane, hi = lane >> 5, q5 = lane & 31;
    const int koff = q5 * KSTR + hi * 16 + kcolB;
    const int voff = KT_BYTES + (4 * hi + ((lane & 15) >> 2)) * VSTR + (16 * ((lane >> 4) & 1) + 4 * (lane & 3)) * 2;
    const float NEGINF = -__builtin_inff();
    unsigned tm = tilemask;
    int jt = __ffs(tm) - 1; tm &= tm - 1;
    u32x4 sr[4];
    stage_load(sr, Kg + (size_t)(64 * jt) * UP, Vg + (size_t)(64 * jt) * UP, UP, X.tid);
    stage_store(X.lds + L_BUF0, sr, X.tid);
    __syncthreads();
    int cur = 0;
    for (;;) {
        const int jn = tm ? (__ffs(tm) - 1) : -1;
        if (jn >= 0) { tm &= tm - 1; stage_load(sr, Kg + (size_t)(64 * jn) * UP, Vg + (size_t)(64 * jn) * UP, UP, X.tid); }
        LAS const unsigned char* buf = X.lds + (cur ? L_BUF1 : L_BUF0);
        const bool lanebit = (selbits >> jt) & 1u;
        const bool skip = (64 * jt > qw0 + 31) || (qw0 - 64 * jt - 63 >= W) || !__any(lanebit);
        if (!skip) {
            f32x16 p0, p1;
            qk_tile<KS>(p0, p1, buf + koff, qf);
            const float bb = s2 * (float)(64 * jt + 4 * hi - refpos);
#pragma unroll
            for (int r = 0; r < 16; ++r) { const int c = (r & 3) + 8 * (r >> 2); p0[r] += fmaf(s2, (float)c, bb); p1[r] += fmaf(s2, (float)(c + 32), bb); }
            const bool needmask = !__all(lanebit) || (64 * jt + 63 > qw0) || (qw0 + 31 - 64 * jt >= W);
            if (needmask) {
                const int dq = qp - 64 * jt - 4 * hi;
#pragma unroll
                for (int r = 0; r < 16; ++r) { const int c = (r & 3) + 8 * (r >> 2);
                    if (!(lanebit && (unsigned)(dq - c) < (unsigned)W)) p0[r] = NEGINF;
                    if (!(lanebit && (unsigned)(dq - c - 32) < (unsigned)W)) p1[r] = NEGINF; }
            }
            float mx = fmaxf(p0[0], p1[0]);
#pragma unroll
            for (int r = 1; r < 16; ++r) mx = fmaxf(mx, fmaxf(p0[r], p1[r]));
            mx = xhalf_max(mx);
            if (!__all(mx - m <= 8.f)) {
                const float mn = fmaxf(m, mx), alpha = __builtin_amdgcn_exp2f(m - mn); m = mn; l *= alpha;
#pragma unroll
                for (int db = 0; db < 4; ++db) o[db] = o[db] * alpha;
            }
            float ps = 0.f;
#pragma unroll
            for (int r = 0; r < 16; ++r) { p0[r] = __builtin_amdgcn_exp2f(p0[r] - m); p1[r] = __builtin_amdgcn_exp2f(p1[r] - m); ps += p0[r] + p1[r]; }
            l += xhalf_sum(ps);
            pv_tile(o, buf + voff, pack8(p0, 0), pack8(p0, 8), pack8(p1, 0), pack8(p1, 8));
        }
        if (jn >= 0) stage_store(X.lds + (cur ? L_BUF0 : L_BUF1), sr, X.tid);
        __syncthreads();
        if (jn < 0) break;
        jt = jn; cur ^= 1;
    }
}

__device__ __forceinline__ void diff_unit(const Ctx& X, const Args& a, int b, int h, int qb) {
    const bf16* U = (const bf16*)(X.ws + WS_U); bf16* CAT = (bf16*)(X.ws + WS_CAT);
    const int w = X.wave, lane = X.lane, c = w >> 2, tq = w & 3, hi = lane >> 5, q5 = lane & 31;
    const int qw0 = 128 * qb + 32 * tq, qp = qw0 + q5;
    const size_t row = (size_t)b * T + qp;
    bf16x8 qf[4];
#pragma unroll
    for (int s = 0; s < 4; ++s) qf[s] = *(const bf16x8*)(U + row * UP + C_QA + 128 * h + 64 * c + 16 * s + 8 * hi);
    const float s2 = exp2f(-2.f * (float)(h + 1)) * LOG2E;
    f32x16 o[4];
#pragma unroll
    for (int db = 0; db < 4; ++db)
#pragma unroll
        for (int r = 0; r < 16; ++r) o[db][r] = 0.f;
    float m = -1e30f, l = 0.f;
    const int nt = 2 * qb + 2;
    const unsigned tilemask = nt >= 32 ? 0xffffffffu : ((1u << nt) - 1u);
    const bf16* Ub = U + (size_t)b * T * UP;
    attend<4>(X, o, m, l, qf, Ub + C_KA + 128 * h, Ub + C_VA + 128 * h, 128 * c, tilemask, qp, qw0, 0x7fffffff, 0xffffffffu, s2, 128 * qb);
    const float inv = 1.f / l;
    LAS float* xch = (LAS float*)(X.lds + L_XCH) + tq * 4096;
    if (c == 1) {
#pragma unroll
        for (int db = 0; db < 4; ++db)
#pragma unroll
            for (int r = 0; r < 16; ++r) xch[(db * 16 + r) * 64 + lane] = o[db][r] * inv;
    }
    __syncthreads();
    if (c == 0) {
        const float d1 = wave_sum(a.in[8][lane] * a.in[9][lane]), d2 = wave_sum(a.in[10][lane] * a.in[11][lane]);
        const float lam = __expf(d1) - __expf(d2) + LAM_INIT;
        float ss = 0.f;
#pragma unroll
        for (int db = 0; db < 4; ++db)
#pragma unroll
            for (int r = 0; r < 16; ++r) { const float v = o[db][r] * inv - lam * xch[(db * 16 + r) * 64 + lane]; o[db][r] = v; ss += v * v; }
        ss = xhalf_sum(ss);
        const float rstd = rsqrtf(ss * (1.f / 128.f) + NORM_EPS) * (1.f - LAM_INIT);
        const float* gsub = a.in[12];
#pragma unroll
        for (int db = 0; db < 4; ++db)
#pragma unroll
            for (int g4 = 0; g4 < 4; ++g4) {
                const int d0 = 32 * db + 8 * g4 + 4 * hi;
                const u32x2 zz = *(const u32x2*)(U + row * UP + C_ZA + 128 * h + d0);
                const f32x4 gv = *(const f32x4*)(gsub + d0);
                const float v0 = o[db][4 * g4 + 0] * rstd * gv.x * silu_f(bflo(zz.x)), v1 = o[db][4 * g4 + 1] * rstd * gv.y * silu_f(bfhi(zz.x));
                const float v2 = o[db][4 * g4 + 2] * rstd * gv.z * silu_f(bflo(zz.y)), v3 = o[db][4 * g4 + 3] * rstd * gv.w * silu_f(bfhi(zz.y));
                u32x2 ov; ov.x = pk2(v0, v1); ov.y = pk2(v2, v3);
                *(u32x2*)(CAT + row * DM + 128 * h + d0) = ov;
            }
    }
    __syncthreads();
}

__device__ __forceinline__ void compress_unit(const Ctx& X, const Args& a, int item) {
    const int kv = item & 1, rg = (item >> 1) & 3, b = item >> 3;
    const bf16* U = (const bf16*)(X.ws + WS_U);
    const bf16* W1t = (const bf16*)(X.ws + (kv ? WS_WV1 : WS_WK1)); const bf16* W2t = (const bf16*)(X.ws + (kv ? WS_WV2 : WS_WK2));
    bf16* outp = (bf16*)(X.ws + (kv ? WS_VCMP : WS_KCMP)) + (size_t)b * 128 * 128;
    const float* B1P = (const float*)(X.ws + WS_B1P);
    const int colbase = kv ? C_VC : C_KC;
    const int w = X.wave, lane = X.lane, hi = lane >> 5, q5 = lane & 31;
    const int cidx = 32 * rg + q5, cc = cidx < NCMP ? cidx : NCMP - 1;
    f32x16 g[4];
#pragma unroll
    for (int nb = 0; nb < 4; ++nb)
#pragma unroll
        for (int r = 0; r < 16; ++r) g[nb][r] = 0.f;
    for (int lt = 4 * w; lt < 4 * w + 4; ++lt) {
        const bf16* arow = U + ((size_t)b * T + 16 * cc + lt) * UP + colbase + 8 * hi;
        const bf16* wrow = W1t + (size_t)q5 * 4096 + lt * 128 + 8 * hi;
#pragma unroll 2
        for (int s = 0; s < 8; ++s) {
            const bf16x8 bfr = *(const bf16x8*)(arow + 16 * s);
#pragma unroll
            for (int nb = 0; nb < 4; ++nb) { const bf16x8 afr = *(const bf16x8*)(wrow + (size_t)nb * 32 * 4096 + 16 * s); g[nb] = MFMA32(afr, bfr, g[nb]); }
        }
    }
    LAS float* red = (LAS float*)X.lds;
    LAS float* bias = (LAS float*)(X.lds + 131072);
    LAS bf16* gact = (LAS bf16*)(X.lds + 131072 + 1024);
#pragma unroll
    for (int nb = 0; nb < 4; ++nb)
#pragma unroll
        for (int r = 0; r < 16; ++r) red[(w * 64 + nb * 16 + r) * 64 + lane] = g[nb][r];
    if (X.tid < 128) { float s = 0.f; for (int p = 0; p < 64; ++p) s += B1P[(kv * 64 + p) * 128 + X.tid]; bias[X.tid] = s; }
    __syncthreads();
#pragma unroll
    for (int ii = 0; ii < 8; ++ii) {
        const int idx = 8 * w + ii; float s = 0.f;
#pragma unroll
        for (int ww = 0; ww < 8; ++ww) s += red[(ww * 64 + idx) * 64 + lane];
        const int n = 32 * (idx >> 4) + crow(idx & 15, hi);
        const float v = gelu_tanh(s + bias[n]);
        gact[q5 * 136 + n] = (bf16)(pk2(v, 0.f) & 0xffffu);
    }
    __syncthreads();
    if (w < 4) {
        f32x16 acc;
#pragma unroll
        for (int r = 0; r < 16; ++r) acc[r] = 0.f;
#pragma unroll
        for (int s = 0; s < 8; ++s) {
            const bf16x8 bfr = *(LAS const bf16x8*)(gact + q5 * 136 + 16 * s + 8 * hi);
            const bf16x8 afr = *(const bf16x8*)(W2t + (size_t)(32 * w + q5) * 128 + 16 * s + 8 * hi);
            acc = MFMA32(afr, bfr, acc);
        }
#pragma unroll
        for (int g4 = 0; g4 < 4; ++g4) {
            const int n2 = 32 * w + 8 * g4 + 4 * hi;
            u32x2 ov; ov.x = pk2(acc[4 * g4 + 0], acc[4 * g4 + 1]); ov.y = pk2(acc[4 * g4 + 2], acc[4 * g4 + 3]);
            if (cidx >= NCMP) { ov.x = 0u; ov.y = 0u; }
            *(u32x2*)(outp + (size_t)cidx * 128 + n2) = ov;
        }
    }
    __syncthreads();
}

__device__ __forceinline__ void nsa_unit(const Ctx& X, const Args& a, int b, int i) {
    const bf16* U = (const bf16*)(X.ws + WS_U); bf16* CAT = (bf16*)(X.ws + WS_CAT); const float* G = (const float*)(X.ws + WS_GATES);
    const int w = X.wave, lane = X.lane, hi = lane >> 5, q5 = lane & 31, h = w >> 1, th = w & 1;
    const int qw0 = 64 * i + 32 * th, qp = qw0 + q5;
    const size_t row = (size_t)b * T + qp;
    bf16x8 qf[8];
#pragma unroll
    for (int s = 0; s < 8; ++s) qf[s] = *(const bf16x8*)(U + row * UP + C_QB + 128 * h + 16 * s + 8 * hi);
    const float s2 = exp2f(-2.f * (float)(h + 1)) * LOG2E;
    const float g0 = G[row * 16 + h], g1 = G[row * 16 + 4 + h], g2 = G[row * 16 + 8 + h];
    f32x4* accp = (f32x4*)((float*)(X.ws + WS_NSAACC) + (((size_t)X.bid * 8 + w) * 64 + lane) * 64);
    const bf16* Ub = U + (size_t)b * T * UP;
    LAS float* imp = (LAS float*)(X.lds + L_XCH);
    LAS unsigned* selm = (LAS unsigned*)(X.lds + L_MISC + 256);
    const float NEGINF = -__builtin_inff();
    const int koff = q5 * KSTR + hi * 16;
    const int voff = KT_BYTES + (4 * hi + ((lane & 15) >> 2)) * VSTR + (16 * ((lane >> 4) & 1) + 4 * (lane & 3)) * 2;
#ifndef NSA_PARTS
#define NSA_PARTS 7
#endif
    if (NSA_PARTS & 1) {
    f32x16 A[4];
#pragma unroll
    for (int db = 0; db < 4; ++db)
#pragma unroll
        for (int r = 0; r < 16; ++r) A[db][r] = 0.f;
    {
        const int nct = (4 * i + 3 + 63) >> 6;
        const bf16* Kc = (const bf16*)(X.ws + WS_KCMP) + (size_t)b * 128 * 128; const bf16* Vc = (const bf16*)(X.ws + WS_VCMP) + (size_t)b * 128 * 128;
        u32x4 sr[4];
        stage_load(sr, Kc, Vc, 128, X.tid); stage_store(X.lds + L_BUF0, sr, X.tid);
        if (nct > 1) { stage_load(sr, Kc + 64 * 128, Vc + 64 * 128, 128, X.tid); stage_store(X.lds + L_BUF1, sr, X.tid); }
        __syncthreads();
        f32x16 p[4];
        qk_tile<8>(p[0], p[1], X.lds + L_BUF0 + koff, qf);
        if (nct > 1) qk_tile<8>(p[2], p[3], X.lds + L_BUF1 + koff, qf);
        else {
#pragma unroll
            for (int r = 0; r < 16; ++r) { p[2][r] = 0.f; p[3][r] = 0.f; }
        }
        float mx = NEGINF;
        int lim = qp - 64 * hi - 31; float bb0 = s2 * (float)(64 * hi + 31 - 64 * i);
        asm volatile("" : "+v"(lim), "+v"(bb0));
#pragma unroll
        for (int hh = 0; hh < 4; ++hh)
#pragma unroll
            for (int r = 0; r < 16; ++r) { const int CC = 16 * (32 * hh + (r & 3) + 8 * (r >> 2));
                const bool ok = (CC <= lim) && (hh < 2 * nct);
                const float t = ok ? p[hh][r] + fmaf(s2, (float)CC, bb0) : NEGINF; p[hh][r] = t; mx = fmaxf(mx, t); }
        mx = xhalf_max(mx);
        const float mm = (mx == NEGINF) ? 0.f : mx;
        float sum = 0.f;
#pragma unroll
        for (int hh = 0; hh < 4; ++hh)
#pragma unroll
            for (int r = 0; r < 16; ++r) { const float e = __builtin_amdgcn_exp2f(p[hh][r] - mm); p[hh][r] = e; sum += e; }
        sum = xhalf_sum(sum);
        const float inv = sum > 0.f ? 1.f / sum : 0.f;
        float av[16], bv[16];
#pragma unroll
        for (int hh = 0; hh < 4; ++hh)
#pragma unroll
            for (int g4 = 0; g4 < 4; ++g4) { const float t3 = 0.5f * p[hh][4 * g4 + 3] * inv;
                av[hh * 4 + g4] = (p[hh][4 * g4] + p[hh][4 * g4 + 1] + p[hh][4 * g4 + 2]) * inv + t3; bv[hh * 4 + g4] = t3; }
#pragma unroll
        for (int idx = 0; idx < 16; ++idx) bv[idx] = __shfl_xor(bv[idx], 32);
#pragma unroll
        for (int idx = 0; idx < 16; ++idx) { const float add = hi ? bv[idx] : (idx > 0 ? bv[idx > 0 ? idx - 1 : 0] : 0.f);
            imp[(h * 64 + 32 * th + q5) * 33 + 2 * idx + hi] = av[idx] + add; }
        const float sc = inv * g0;
#pragma unroll
        for (int hh = 0; hh < 4; ++hh) p[hh] = p[hh] * sc;
        pv_tile(A, X.lds + L_BUF0 + voff, pack8(p[0], 0), pack8(p[0], 8), pack8(p[1], 0), pack8(p[1], 8));
        if (nct > 1) pv_tile(A, X.lds + L_BUF1 + voff, pack8(p[2], 0), pack8(p[2], 8), pack8(p[3], 0), pack8(p[3], 8));
        __syncthreads();
        if (w == 0) {
            unsigned mask;
            if (i + 1 <= 8) mask = (1u << (i + 1)) - 1u;
            else {
                LAS float* s0 = imp + lane * 33;
                for (int j = 1; j < i; ++j) s0[j] = ((s0[j] + imp[(64 + lane) * 33 + j]) + imp[(128 + lane) * 33 + j]) + imp[(192 + lane) * 33 + j];
                mask = 1u | (1u << i);
                for (int k = 0; k < 6; ++k) { float best = NEGINF; int bj = 1;
                    for (int j = 1; j < i; ++j) { const float s = s0[j]; if (!((mask >> j) & 1u) && s > best) { best = s; bj = j; } }
                    mask |= 1u << bj; }
            }
            selm[lane] = mask;
            unsigned um = mask;
#pragma unroll
            for (int o = 1; o < 64; o <<= 1) um |= __shfl_xor(um, o);
            if (lane == 0) selm[64] = um;
        }
        __syncthreads();
    }
#pragma unroll
    for (int db = 0; db < 4; ++db)
#pragma unroll
        for (int g4 = 0; g4 < 4; ++g4) accp[db * 4 + g4] = (f32x4){A[db][4 * g4], A[db][4 * g4 + 1], A[db][4 * g4 + 2], A[db][4 * g4 + 3]};
    }
    f32x16 o[4]; float m, l;
    if (NSA_PARTS & 2) {
        const unsigned uni = selm[64], mybits = selm[32 * th + q5];
#pragma unroll
        for (int db = 0; db < 4; ++db)
#pragma unroll
            for (int r = 0; r < 16; ++r) o[db][r] = 0.f;
        m = -1e30f; l = 0.f;
        attend<8>(X, o, m, l, qf, Ub + C_KS, Ub + C_VS, 0, uni, qp, qw0, 0x7fffffff, mybits, s2, 64 * i);
        const float sc = g1 / l;
#pragma unroll
        for (int db = 0; db < 4; ++db)
#pragma unroll
            for (int g4 = 0; g4 < 4; ++g4) { f32x4 v = accp[db * 4 + g4];
                v.x += o[db][4 * g4] * sc; v.y += o[db][4 * g4 + 1] * sc; v.z += o[db][4 * g4 + 2] * sc; v.w += o[db][4 * g4 + 3] * sc; accp[db * 4 + g4] = v; }
    }
    if (NSA_PARTS & 4) {
        const int j0 = i >= 4 ? i - 4 : 0;
        const unsigned wmask = (i >= 31 ? 0xffffffffu : ((1u << (i + 1)) - 1u)) & ~((1u << j0) - 1u);
#pragma unroll
        for (int db = 0; db < 4; ++db)
#pragma unroll
            for (int r = 0; r < 16; ++r) o[db][r] = 0.f;
        m = -1e30f; l = 0.f;
        attend<8>(X, o, m, l, qf, Ub + C_KW, Ub + C_VW, 0, wmask, qp, qw0, 256, 0xffffffffu, s2, 64 * i);
        const float sc = g2 / l;
#pragma unroll
        for (int db = 0; db < 4; ++db)
#pragma unroll
            for (int g4 = 0; g4 < 4; ++g4) { const f32x4 v = accp[db * 4 + g4];
                o[db][4 * g4] = v.x + o[db][4 * g4] * sc; o[db][4 * g4 + 1] = v.y + o[db][4 * g4 + 1] * sc; o[db][4 * g4 + 2] = v.z + o[db][4 * g4 + 2] * sc; o[db][4 * g4 + 3] = v.w + o[db][4 * g4 + 3] * sc; }
    }
#pragma unroll
    for (int db = 0; db < 4; ++db)
#pragma unroll
        for (int g4 = 0; g4 < 4; ++g4) {
            const int d0 = 32 * db + 8 * g4 + 4 * hi;
            const u32x2 zz = *(const u32x2*)(U + row * UP + C_ZB + 128 * h + d0);
            const float v0 = o[db][4 * g4 + 0] * silu_f(bflo(zz.x)), v1 = o[db][4 * g4 + 1] * silu_f(bfhi(zz.x));
            const float v2 = o[db][4 * g4 + 2] * silu_f(bflo(zz.y)), v3 = o[db][4 * g4 + 3] * silu_f(bfhi(zz.y));
            u32x2 ov; ov.x = pk2(v0, v1); ov.y = pk2(v2, v3);
            *(u32x2*)(CAT + row * DM + 512 + 128 * h + d0) = ov;
        }
}

__device__ __forceinline__ int q_next(const Ctx& X, unsigned* ctr) {
    LAS int* slot = (LAS int*)(X.lds + L_MISC);
    __syncthreads();
    if (X.tid == 0) *slot = (int)atomicAdd(ctr, 1u) + X.G;
    __syncthreads();
    return *slot;
}

__global__ void __launch_bounds__(512, 2) fwd_kernel(Args a) {
    extern __shared__ __attribute__((aligned(16))) unsigned char lds_raw[];
    Ctx X;
    X.lds = (LAS unsigned char*)lds_raw; X.ws = a.ws;
    X.tid = threadIdx.x; X.lane = X.tid & 63; X.wave = __builtin_amdgcn_readfirstlane(X.tid >> 6); X.G = gridDim.x; X.bid = blockIdx.x;
    cg::grid_group grid = cg::this_grid();
    const int lo = a.ph_lo, hi = a.ph_hi;
    volatile LAS unsigned* xst = (volatile LAS unsigned*)(X.lds + L_MISC + 1024);
    if (X.tid < 4) xst[X.tid] = 0u;
    __syncthreads();
    XcdBarrier bar = xcd_barrier_post((unsigned*)(X.ws + WS_CTL) + CW_BAR, xst);
    if (a.ph_lo < 0) grid.sync();
#ifndef PH_MASK
#define PH_MASK 0x7f
#endif
#define IN(k) (((PH_MASK >> (k)) & 1) && lo <= (k) && (k) < hi)
#define SEAM(k) do { if (IN(k) && IN((k) + 1)) { if ((k) == CG_SEAM) grid.sync(); else xcd_barrier(bar); } } while (0)
#ifndef CG_SEAM
#define CG_SEAM 99
#endif
    if (IN(0)) p0_prologue(X, a);
    SEAM(0);
    if (IN(1)) p1_norm(X, a);
    SEAM(1);
    if (IN(2)) {
        pg8::Gemm g{(const pg8::bf16_t*)(X.ws + WS_H), (const pg8::bf16_t*)(X.ws + WS_WIN), M, UP, 1024};
        pg8::StaticOrder S; S.init(M, UP, X.G, X.bid);
        pg8::EpiBf16<0> E{(pg8::bf16_t*)(X.ws + WS_U), UP, nullptr, 0, 0, 1.f};
        pg8::gemm_phase<pg8::EpiBf16<0>, pg8::StaticOrder, true, true>(X.lds, g, S, E);
    }
    SEAM(2);
    if (IN(3)) {
        unsigned* ctr = (unsigned*)(X.ws + WS_CTL) + CW_Q3;
        constexpr int NITEMS = 128 + 1024;
        int it = X.bid;
        for (; it < 128; it = q_next(X, ctr)) compress_unit(X, a, it);
        for (; it < NITEMS; it = q_next(X, ctr)) { const int u = it - 128, qb = 15 - (u >> 6), bh = u & 63; diff_unit(X, a, bh >> 2, bh & 3, qb); }
    }
    SEAM(3);
    if (IN(4)) {
        unsigned* ctr = (unsigned*)(X.ws + WS_CTL) + CW_Q4;
        for (int it = X.bid; it < 512; it = q_next(X, ctr)) { const int i = 31 - (it >> 4), b = it & 15; nsa_unit(X, a, b, i); }
    }
    SEAM(4);
    if (IN(5)) {
        pg8::Gemm g{(const pg8::bf16_t*)(X.ws + WS_CAT), (const pg8::bf16_t*)(X.ws + WS_WOUT), M, DM, 1024};
        pg8::StaticOrder S; S.init(M, DM, X.G, X.bid);
        pg8::EpiBf16<0> E{(pg8::bf16_t*)(X.ws + WS_Y), DM, nullptr, 0, 0, 1.f};
        pg8::gemm_phase<pg8::EpiBf16<0>, pg8::StaticOrder, true, true>(X.lds, g, S, E);
    }
    SEAM(5);
    if (IN(6)) p6_final(X, a);
#undef IN
#undef SEAM
}

#ifndef N_LAUNCHES
#define N_LAUNCHES 1
#endif
extern "C" void kernel_launch(void* const* d_in, const int* in_sizes, int n_in, void* d_out, int out_size, void* d_ws, size_t ws_size, hipStream_t stream) {
    static int grid = 0;
    if (grid == 0) {
        if (n_in != 18 || in_sizes[0] != M * DM || out_size != M * DM || ws_size < WS_END) { fprintf(stderr, "kernel_launch: unexpected shapes (n_in %d, in0 %d, out %d, ws %zu)\n", n_in, n_in > 0 ? in_sizes[0] : -1, out_size, ws_size); grid = -1; return; }
        int dev = 0, cus = 0, per_cu = 0;
        (void)hipGetDevice(&dev); (void)hipDeviceGetAttribute(&cus, hipDeviceAttributeMultiprocessorCount, dev);
        if (hipFuncSetAttribute((const void*)fwd_kernel, hipFuncAttributeMaxDynamicSharedMemorySize, LDS_BYTES) != hipSuccess) { fprintf(stderr, "kernel_launch: hipFuncSetAttribute failed\n"); grid = -1; return; }
        if (hipOccupancyMaxActiveBlocksPerMultiprocessor(&per_cu, (const void*)fwd_kernel, 512, LDS_BYTES) != hipSuccess || per_cu < 1) { fprintf(stderr, "kernel_launch: occupancy query says %d blocks/CU\n", per_cu); per_cu = 1; }
        (void)hipGetLastError();
        grid = cus;
        fprintf(stderr, "kernel_launch: grid %d (cus %d, per_cu %d)\n", grid, cus, per_cu);
    }
    if (grid < 0) return;
    (void)hipMemsetAsync((char*)d_ws + WS_CTL, 0, CTL_BYTES, stream);
    Args a{};
    for (int i = 0; i < 18; ++i) a.in[i] = (const float*)d_in[i];
    a.out = (float*)d_out; a.ws = (unsigned char*)d_ws;
    if (N_LAUNCHES == 1) {
        a.ph_lo = 0; a.ph_hi = 7;
        void* args[] = {&a};
        hipError_t e = hipLaunchCooperativeKernel((const void*)fwd_kernel, dim3(grid), dim3(512), args, LDS_BYTES, stream);
        if (e != hipSuccess) fprintf(stderr, "cooperative launch failed: %s (grid %d)\n", hipGetErrorString(e), grid);
    } else {
        for (int p = 0; p < 7; ++p) { a.ph_lo = p; a.ph_hi = p + 1; hipLaunchKernelGGL(fwd_kernel, dim3(grid), dim3(512), LDS_BYTES, stream, a); }
    }
}
```
